# Optimizing an MI355X kernel written in HIP

```python
import jax, jax.numpy as jnp
from jax import lax
import numpy as np

D_MODEL = 1024
BATCH = 16
SEQ = 2048
DEPTH = 1

HEAD_DIM = 64
A_Q_HEADS = 8
A_KV_HEADS = 2
A_GROUP = A_Q_HEADS // A_KV_HEADS
A_WINDOW = 128
B_HEADS = 8
B_BRANCHES = ((128, 1), (512, 4), (2048, 16))
ROT_DIM = HEAD_DIM // 4
ROPE_THETA = 500000.0
D_FF = 4 * D_MODEL
A_Q_W = A_Q_HEADS * HEAD_DIM
A_KV_W = A_KV_HEADS * HEAD_DIM
B_W = B_HEADS * HEAD_DIM
MIX_W = A_Q_W + B_W
IN_W = A_Q_W + 2 * A_KV_W + 3 * B_W
N_MOD = 6
BLOCK = 128
EPS = 1e-6
NEG_INF = -1e30

kernel_name = 'hybrid_swa_sink_dilated_sqrelu_block'


def rms_norm(x, g):
    xf = x.astype(jnp.float32)
    y = xf * lax.rsqrt(jnp.mean(xf * xf, axis=-1, keepdims=True) + EPS)
    return (y * g.astype(jnp.float32)).astype(x.dtype)


def partial_rope(x, cos, sin):
    half = ROT_DIM // 2
    x1 = x[..., :half].astype(jnp.float32)
    x2 = x[..., half:ROT_DIM].astype(jnp.float32)
    rot = jnp.concatenate([x1 * cos - x2 * sin, x2 * cos + x1 * sin], axis=-1).astype(x.dtype)
    return jnp.concatenate([rot, x[..., ROT_DIM:]], axis=-1)


def banded_attention(q, k, v, max_dist, sink=None, return_lse=False):
    n, seq_len, hk, g, dh = q.shape
    blk = min(BLOCK, seq_len)
    nb = -(-seq_len // blk)
    lp = nb * blk
    pad = lp - seq_len
    if pad:
        q = jnp.pad(q, ((0, 0), (0, pad), (0, 0), (0, 0), (0, 0)))
        k = jnp.pad(k, ((0, 0), (0, pad), (0, 0), (0, 0)))
        v = jnp.pad(v, ((0, 0), (0, pad), (0, 0), (0, 0)))
    qb = q.reshape(n, nb, blk, hk, g, dh)
    kb = k.reshape(n, nb, blk, hk, dh)
    vb = v.reshape(n, nb, blk, hk, dh)
    kcat = jnp.concatenate([jnp.pad(kb, ((0, 0), (1, 0), (0, 0), (0, 0), (0, 0)))[:, :nb], kb], axis=2)
    vcat = jnp.concatenate([jnp.pad(vb, ((0, 0), (1, 0), (0, 0), (0, 0), (0, 0)))[:, :nb], vb], axis=2)
    s = jnp.einsum('ncqhgd,nckhd->nhgcqk', qb, kcat,
                   preferred_element_type=jnp.float32) * (1.0 / float(np.sqrt(dh)))
    blocks = jnp.arange(nb)[:, None, None]
    qpos = blocks * blk + jnp.arange(blk)[None, :, None]
    kpos = (blocks - 1) * blk + jnp.arange(2 * blk)[None, None, :]
    dist = qpos - kpos
    valid = (dist >= 0) & (dist <= max_dist) & (kpos >= 0)
    s = jnp.where(valid, s, NEG_INF)
    m = jnp.max(s, axis=-1, keepdims=True)
    if sink is not None:
        sk = sink.astype(jnp.float32).reshape(hk, g)[None, :, :, None, None, None]
        m = jnp.maximum(m, sk)
        p = jnp.exp(s - m)
        denom = jnp.sum(p, axis=-1, keepdims=True) + jnp.exp(sk - m)
    else:
        p = jnp.exp(s - m)
        denom = jnp.sum(p, axis=-1, keepdims=True)
    o = jnp.einsum('nhgcqk,nckhd->ncqhgd', p / denom, vcat.astype(jnp.float32))
    o = o.reshape(n, lp, hk, g, dh)[:, :seq_len]
    if return_lse:
        lse = (m + jnp.log(denom))[..., 0]
        lse = lse.transpose(0, 3, 4, 1, 2).reshape(n, lp, hk, g)[:, :seq_len]
        return o, lse
    return o


def dilated_mixture_attention(q, k, v):
    b, s, h, dh = q.shape
    outs, lses = [], []
    for window, d in B_BRANCHES:
        sub = s // d

        def to_sub(t):
            return t.reshape(b, sub, d, h, dh).transpose(0, 2, 1, 3, 4).reshape(b * d, sub, h, dh)

        o, lse = banded_attention(to_sub(q)[:, :, :, None, :], to_sub(k), to_sub(v),
                                  window // d, return_lse=True)
        outs.append(o[:, :, :, 0].reshape(b, d, sub, h, dh).transpose(0, 2, 1, 3, 4).reshape(b, s, h, dh))
        lses.append(lse[..., 0].reshape(b, d, sub, h).transpose(0, 2, 1, 3).reshape(b, s, h))
    w = jax.nn.softmax(jnp.stack(lses, axis=0), axis=0)
    return jnp.sum(w[..., None] * jnp.stack(outs, axis=0), axis=0)


def setup_inputs(seed: int = 0) -> dict:
    key = jax.random.key(seed)
    ks = jax.random.split(key, 17)
    f32 = jnp.float32

    def gain(k, n):
        return 1.0 + 0.05 * jax.random.normal(k, (DEPTH, n), f32)

    x = jax.random.normal(ks[0], (BATCH, SEQ, D_MODEL), f32)
    c = jax.random.normal(ks[1], (BATCH, D_MODEL), f32)
    offsets = jax.random.randint(ks[2], (BATCH, 1), 0, 1024, dtype=jnp.int32)
    positions = offsets + jnp.arange(SEQ, dtype=jnp.int32)[None, :]
    w_ada = jax.random.normal(ks[3], (DEPTH, D_MODEL, N_MOD * D_MODEL), f32) * D_MODEL ** -0.5
    b_ada = 0.02 * jax.random.normal(ks[4], (DEPTH, N_MOD * D_MODEL), f32)
    g_attn_pre = gain(ks[5], D_MODEL)
    g_attn_post = gain(ks[6], D_MODEL)
    w_in = jax.random.normal(ks[7], (DEPTH, D_MODEL, IN_W), f32) * D_MODEL ** -0.5
    sink_a = jax.random.normal(ks[8], (DEPTH, A_Q_HEADS), f32)
    g_mix_a = gain(ks[9], A_Q_W)
    g_mix_b = gain(ks[10], B_W)
    w_out = jax.random.normal(ks[11], (DEPTH, MIX_W, D_MODEL), f32) * MIX_W ** -0.5
    g_mlp_pre = gain(ks[12], D_MODEL)
    g_mlp_post = gain(ks[13], D_MODEL)
    w_up = jax.random.normal(ks[14], (DEPTH, D_MODEL, D_FF), f32) * D_MODEL ** -0.5
    w_down = jax.random.normal(ks[15], (DEPTH, D_FF, D_MODEL), f32) * D_FF ** -0.5
    return {'x': x, 'c': c, 'positions': positions, 'w_ada': w_ada, 'b_ada': b_ada,
            'g_attn_pre': g_attn_pre, 'g_attn_post': g_attn_post, 'w_in': w_in,
            'sink_a': sink_a, 'g_mix_a': g_mix_a, 'g_mix_b': g_mix_b, 'w_out': w_out,
            'g_mlp_pre': g_mlp_pre, 'g_mlp_post': g_mlp_post, 'w_up': w_up, 'w_down': w_down}


def reference(x, c, positions, w_ada, b_ada, g_attn_pre, g_attn_post, w_in, sink_a,
              g_mix_a, g_mix_b, w_out, g_mlp_pre, g_mlp_post, w_up, w_down):
    b, s, _ = x.shape
    inv_freq = ROPE_THETA ** (-jnp.arange(0, ROT_DIM, 2, dtype=jnp.float32) / ROT_DIM)
    ang = positions.astype(jnp.float32)[..., None] * inv_freq
    cos = jnp.cos(ang)[:, :, None, :]
    sin = jnp.sin(ang)[:, :, None, :]
    cond = jax.nn.silu(c)
    o1 = A_Q_W
    o2 = o1 + A_KV_W
    o3 = o2 + A_KV_W
    o4 = o3 + B_W
    o5 = o4 + B_W
    for l in range(DEPTH):
        mod = (cond @ w_ada[l] + b_ada[l]).astype(x.dtype)
        sh_a, sc_a, gt_a, sh_m, sc_m, gt_m = [m[:, None, :] for m in jnp.split(mod, N_MOD, axis=-1)]

        h = rms_norm(x, g_attn_pre[l]) * (1 + sc_a) + sh_a
        proj = h @ w_in[l]
        qa = partial_rope(proj[..., :o1].reshape(b, s, A_Q_HEADS, HEAD_DIM), cos, sin)
        ka = partial_rope(proj[..., o1:o2].reshape(b, s, A_KV_HEADS, HEAD_DIM), cos, sin)
        va = proj[..., o2:o3].reshape(b, s, A_KV_HEADS, HEAD_DIM)
        qb = partial_rope(proj[..., o3:o4].reshape(b, s, B_HEADS, HEAD_DIM), cos, sin)
        kb = partial_rope(proj[..., o4:o5].reshape(b, s, B_HEADS, HEAD_DIM), cos, sin)
        vb = proj[..., o5:].reshape(b, s, B_HEADS, HEAD_DIM)

        oa = banded_attention(qa.reshape(b, s, A_KV_HEADS, A_GROUP, HEAD_DIM), ka, va,
                              A_WINDOW - 1, sink=sink_a[l])
        oa = oa.reshape(b, s, A_Q_W).astype(x.dtype)
        ob = dilated_mixture_attention(qb, kb, vb).reshape(b, s, B_W).astype(x.dtype)

        mixed = jnp.concatenate([rms_norm(oa, g_mix_a[l]), rms_norm(ob, g_mix_b[l])], axis=-1)
        y = mixed @ w_out[l]
        x = x + gt_a * rms_norm(y, g_attn_post[l])

        h = rms_norm(x, g_mlp_pre[l]) * (1 + sc_m) + sh_m
        y = jnp.square(jax.nn.relu(h @ w_up[l])) @ w_down[l]
        x = x + gt_m * rms_norm(y, g_mlp_post[l])
    return x
```

```cpp
#include <hip/hip_cooperative_groups.h>
#include <hip/hip_runtime.h>
#include <cstdio>
#include <cstdint>
namespace pg8 {
#define PG8_LAS __attribute__((address_space(3)))
typedef unsigned short bf16_t;
typedef short bf16x8 __attribute__((ext_vector_type(8)));
typedef float f32x4 __attribute__((ext_vector_type(4)));
typedef unsigned u32x4 __attribute__((ext_vector_type(4)));
constexpr int BM = 256, BK = 64, HALF = 128, HTB = HALF * BK * 2  , STAGE_BYTES = 8 * HTB, NXCD = 8, WGM = 8;

__host__ __device__ __forceinline__ int lds_byte(int r, int c) { const int st = (r >> 4) * 2 + (c >> 5), rr = r & 15, cc = c & 31, ob = rr * 64 + cc * 2; return st * 1024 + (ob ^ (((ob >> 9) & 1) << 5)); }
__host__ __device__ __forceinline__ void stage_rc(int b, int& R, int& C) { const int st = b / 1024, sb = b % 1024, swz = sb ^ (((sb >> 9) & 1) << 5); R = (st >> 1) * 16 + swz / 64; C = (st & 1) * 32 + (swz % 64) / 2; }
__host__ __device__ __forceinline__ int perm32(int rho) { const int n = rho >> 4, i = rho & 15; return 8 * (i >> 2) + 4 * n + (i & 3); }

struct Unit { int pm, pn; };
struct Gemm { const bf16_t* A; const bf16_t* Bt; int M, N, K; };

struct StaticOrder {
    int nM, nN, nwg, G, c;
    __host__ __device__ void init(int M, int N, int G_, int c_) { nM = M / BM; nN = N / BM; nwg = nM * nN; G = G_; c = c_; }
    __host__ __device__ bool next(int i, Unit& u) const {
        const long L = (long)i * G + c; if (L >= nwg) return false;
        int wgid = (int)L; { const int q = nwg / NXCD, r = nwg % NXCD, xcd = wgid % NXCD, off = wgid / NXCD; wgid = (xcd < r ? xcd * (q + 1) : r * (q + 1) + (xcd - r) * q) + off; }
        const int nig = WGM * nN, gid = wgid / nig, fm = gid * WGM, gsz = (nM - fm) < WGM ? (nM - fm) : WGM;
        u.pm = fm + ((wgid % nig) % gsz); u.pn = (wgid % nig) / gsz; return true;
    }
    __device__ __forceinline__ void a_ready(const Unit&) const {}
    __device__ __forceinline__ void done(const Unit&) const {}
};

__device__ __forceinline__ unsigned cvt_pk_bf16(float lo, float hi) { unsigned r; asm volatile("v_cvt_pk_bf16_f32 %0, %1, %2" : "=v"(r) : "v"(lo), "v"(hi)); return r; }
typedef float f32x2 __attribute__((ext_vector_type(2)));
__device__ __forceinline__ f32x2 gelu_pk(f32x2 v) {
    const f32x2 av = __builtin_elementwise_abs(v), d = av * 0.2316418882f + 1.0f;
    f32x2 t; t.x = __builtin_amdgcn_rcpf(d.x); t.y = __builtin_amdgcn_rcpf(d.y);
    f32x2 q = t * 0.5307027145f + (-0.7265760135f); q = q * t + 0.7107068705f; q = q * t + (-0.142248368f); q = q * t + 0.127414796f; q = q * t;
    const f32x2 s = (v * v) * (-0.72134752044f);
    f32x2 e; e.x = __builtin_amdgcn_exp2f(s.x); e.y = __builtin_amdgcn_exp2f(s.y);
    const f32x2 m = v * (q * e), r = v - m;
    f32x2 o; o.x = v.x < 0.f ? m.x : r.x; o.y = v.y < 0.f ? m.y : r.y; return o;
}

template <int ACT  > struct EpiBf16 {
    static constexpr bool PERM = true, AFTER_DRAIN = false; static_assert(ACT == 0 || ACT == 1, "EpiBf16: ACT is 0 (none) or 1 (gelu_pk)");
    bf16_t* O; int ldc; const float* bias; int split_cols; size_t split_stride; float scale0;
    __device__ __forceinline__ void operator()(const f32x4 (&acc)[2][2][4][2], const Unit& u, int wr, int wc, int fr, int fq) const {
        const int row0 = u.pm * BM + wr * 64 + fr; int colt = u.pn * BM; bf16_t* base = O;
        float sc = 1.f; if (split_cols) { const int t = colt / split_cols; base += (size_t)t * split_stride; colt -= t * split_cols; if (t == 0) sc = scale0; }
        const int col0 = colt + wc * 32 + 8 * fq, bcol0 = u.pn * BM + wc * 32 + 8 * fq;
        f32x4 bv[2][2];
#pragma unroll
        for (int bj = 0; bj < 2; ++bj)
#pragma unroll
            for (int n = 0; n < 2; ++n) bv[bj][n] = bias ? *(const f32x4*)(bias + bcol0 + bj * HALF + 4 * n) : (f32x4){0.f, 0.f, 0.f, 0.f};
#pragma unroll
        for (int ai = 0; ai < 2; ++ai)
#pragma unroll
            for (int m = 0; m < 4; ++m) { bf16_t* rowp = base + (size_t)(row0 + ai * HALF + m * 16) * ldc + col0;
#pragma unroll
                for (int bj = 0; bj < 2; ++bj) { f32x4 v0 = acc[ai][bj][m][0] + bv[bj][0], v1 = acc[ai][bj][m][1] + bv[bj][1];
                    if (ACT == 1) { f32x2 a = gelu_pk((f32x2){v0[0], v0[1]}), b = gelu_pk((f32x2){v0[2], v0[3]}), c = gelu_pk((f32x2){v1[0], v1[1]}), d = gelu_pk((f32x2){v1[2], v1[3]});
                        v0 = (f32x4){a.x, a.y, b.x, b.y}; v1 = (f32x4){c.x, c.y, d.x, d.y}; }
                    v0 = v0 * sc; v1 = v1 * sc; u32x4 w; w.x = cvt_pk_bf16(v0[0], v0[1]); w.y = cvt_pk_bf16(v0[2], v0[3]); w.z = cvt_pk_bf16(v1[0], v1[1]); w.w = cvt_pk_bf16(v1[2], v1[3]);
                    *(u32x4*)(rowp + bj * HALF) = w; } }
    }
};

struct EpiProj {
    static constexpr bool PERM = true, AFTER_DRAIN = false;
    bf16_t* O; int ldc; const float* rope;
    __device__ __forceinline__ void operator()(const f32x4 (&acc)[2][2][4][2], const Unit& u, int wr, int wc, int fr, int fq) const {
        const int row0 = u.pm * BM + wr * 64 + fr; const int colt = u.pn * BM; const int col0 = colt + wc * 32 + 8 * fq;
        const bool wrot = (wc & 1) == 0;
        const float sgn = (fq == 0) ? -1.f : 1.f;
#pragma unroll
        for (int ai = 0; ai < 2; ++ai)
#pragma unroll
            for (int m = 0; m < 4; ++m) {
                const int row = row0 + ai * HALF + m * 16;
                bf16_t* rowp = O + (size_t)row * ldc + col0;
                f32x4 c0v = {1.f, 1.f, 1.f, 1.f}, c1v = c0v, s0v = {0.f, 0.f, 0.f, 0.f}, s1v = s0v;
                if (wrot) { const f32x4* rp = (const f32x4*)(rope + (size_t)row * 16); c0v = rp[0]; c1v = rp[1]; s0v = rp[2] * sgn; s1v = rp[3] * sgn; }
#pragma unroll
                for (int bj = 0; bj < 2; ++bj) {
                    f32x4 v0 = acc[ai][bj][m][0], v1 = acc[ai][bj][m][1];
                    const int cb = colt + bj * HALF;
                    const bool rot = wrot && (cb < 640 || (cb >= 768 && cb < 1792));
                    if (rot) {
                        f32x4 p0, p1;
#pragma unroll
                        for (int j = 0; j < 4; ++j) { p0[j] = __shfl_xor(v0[j], 16); p1[j] = __shfl_xor(v1[j], 16); }
                        if (fq < 2) { v0 = v0 * c0v + p0 * s0v; v1 = v1 * c1v + p1 * s1v; }
                    }
                    u32x4 w; w.x = cvt_pk_bf16(v0[0], v0[1]); w.y = cvt_pk_bf16(v0[2], v0[3]); w.z = cvt_pk_bf16(v1[0], v1[1]); w.w = cvt_pk_bf16(v1[2], v1[3]);
                    *(u32x4*)(rowp + bj * HALF) = w;
                }
            }
    }
};
struct EpiSqRelu {
    static constexpr bool PERM = true, AFTER_DRAIN = false;
    bf16_t* O; int ldc;
    __device__ __forceinline__ void operator()(const f32x4 (&acc)[2][2][4][2], const Unit& u, int wr, int wc, int fr, int fq) const {
        const int row0 = u.pm * BM + wr * 64 + fr; const int col0 = u.pn * BM + wc * 32 + 8 * fq;
#pragma unroll
        for (int ai = 0; ai < 2; ++ai)
#pragma unroll
            for (int m = 0; m < 4; ++m) { bf16_t* rowp = O + (size_t)(row0 + ai * HALF + m * 16) * ldc + col0;
#pragma unroll
                for (int bj = 0; bj < 2; ++bj) { f32x4 v0 = acc[ai][bj][m][0], v1 = acc[ai][bj][m][1];
                    v0 = __builtin_elementwise_max(v0, (f32x4){0.f, 0.f, 0.f, 0.f}); v1 = __builtin_elementwise_max(v1, (f32x4){0.f, 0.f, 0.f, 0.f}); v0 = v0 * v0; v1 = v1 * v1;
                    u32x4 w; w.x = cvt_pk_bf16(v0[0], v0[1]); w.y = cvt_pk_bf16(v0[2], v0[3]); w.z = cvt_pk_bf16(v1[0], v1[1]); w.w = cvt_pk_bf16(v1[2], v1[3]);
                    *(u32x4*)(rowp + bj * HALF) = w; } }
    }
};
struct EpiF32 {
    static constexpr bool PERM = true, AFTER_DRAIN = false;
    float* O; int ldc;
    __device__ __forceinline__ void operator()(const f32x4 (&acc)[2][2][4][2], const Unit& u, int wr, int wc, int fr, int fq) const {
        const int row0 = u.pm * BM + wr * 64 + fr; const int col0 = u.pn * BM + wc * 32 + 8 * fq;
#pragma unroll
        for (int ai = 0; ai < 2; ++ai)
#pragma unroll
            for (int m = 0; m < 4; ++m) { float* rowp = O + (size_t)(row0 + ai * HALF + m * 16) * ldc + col0;
#pragma unroll
                for (int bj = 0; bj < 2; ++bj) { *(f32x4*)(rowp + bj * HALF) = acc[ai][bj][m][0]; *(f32x4*)(rowp + bj * HALF + 4) = acc[ai][bj][m][1]; } }
    }
};
template <class Epi, class Sched, bool ALIGN_EPI = false, bool SP2 = false>
__device__ __forceinline__ void gemm_phase(PG8_LAS unsigned char* lds, const Gemm g, const Sched& S, const Epi& E) {
    const int tid = threadIdx.x, wid = __builtin_amdgcn_readfirstlane(tid >> 6), lane = tid & 63, wr = wid >> 2, wc = wid & 3, fr = lane & 15, fq = lane >> 4;
    const int K = g.K, nt = K / BK;
    unsigned voffA[2], voffB[2];
#pragma unroll
    for (int i = 0; i < 2; ++i) { int R, C; stage_rc(tid * 16 + i * 8192, R, C); const int Rb = Epi::PERM ? ((R & ~31) + perm32(R & 31)) : R;
        voffA[i] = (unsigned)(R * K + C) * 2u; voffB[i] = (unsigned)(Rb * K + C) * 2u; }
    const size_t kstep = (size_t)(BK * 2);
    const size_t hstep = (size_t)HALF * K * 2;
    const size_t tstep = 2 * hstep;
    const unsigned ldsw = (unsigned)wid * 1024u;
    const int aoff = lds_byte(wr * 64 + fr, fq * 8), boff = lds_byte(wc * 32 + fr, fq * 8);
#define PG8_SA(b, h) (((b) * 2 + (h)) * HTB)
#define PG8_SB(b, h) ((4 + (b) * 2 + (h)) * HTB)
#define PG8_STAGE(bufoff, gbase, voff) do { _Pragma("unroll") for (int _i = 0; _i < 2; ++_i) \
        __builtin_amdgcn_global_load_lds((const unsigned*)((const char*)(gbase) + (voff)[_i]), (PG8_LAS unsigned*)(lds + (bufoff) + ldsw + _i * 8192), 16, 0, 0); } while (0)
#define PG8_LDA(dst, b, h) do { _Pragma("unroll") for (int m = 0; m < 4; ++m) _Pragma("unroll") for (int k = 0; k < 2; ++k) dst[m][k] = *(const PG8_LAS bf16x8*)(lds + PG8_SA(b, h) + aoff + m * 2048 + k * 1024); } while (0)
#define PG8_LDB(dst, b, h) do { _Pragma("unroll") for (int n = 0; n < 2; ++n) _Pragma("unroll") for (int k = 0; k < 2; ++k) dst[n][k] = *(const PG8_LAS bf16x8*)(lds + PG8_SB(b, h) + boff + n * 2048 + k * 1024); } while (0)
#define PG8_MMA(ai, bj, At, Bt) do { __builtin_amdgcn_s_setprio(1); _Pragma("unroll") for (int m = 0; m < 4; ++m) _Pragma("unroll") for (int n = 0; n < 2; ++n) _Pragma("unroll") for (int k = 0; k < 2; ++k) \
        acc[ai][bj][m][n] = __builtin_amdgcn_mfma_f32_16x16x32_bf16(Bt[n][k], At[m][k], acc[ai][bj][m][n], 0, 0, 0); __builtin_amdgcn_s_setprio(0); } while (0)
#define PG8_WAIT_V(n) asm volatile("s_waitcnt vmcnt(" #n ")" ::: "memory")
#define PG8_WAIT_L(n) asm volatile("s_waitcnt lgkmcnt(" #n ")" ::: "memory")
#define PG8_BAR __builtin_amdgcn_s_barrier()
#define PG8_SCHED __builtin_amdgcn_sched_barrier(0)
    Unit cur, nxt; int ui = 0;
    if (!S.next(0, cur)) return;
    f32x4 acc[2][2][4][2];
#pragma unroll
    for (int a = 0; a < 2; ++a)
#pragma unroll
        for (int b = 0; b < 2; ++b)
#pragma unroll
            for (int m = 0; m < 4; ++m)
#pragma unroll
                for (int n = 0; n < 2; ++n) acc[a][b][m][n] = (f32x4){0.f, 0.f, 0.f, 0.f};
    bf16x8 At[4][2], B0[2][2], B1[2][2];
    const char* cA = (const char*)g.A + (size_t)cur.pm * tstep; const char* cB = (const char*)g.Bt + (size_t)cur.pn * tstep;
    S.a_ready(cur);
    if constexpr (SP2) {
        PG8_STAGE(PG8_SB(0, 0), cB, voffB); PG8_STAGE(PG8_SB(0, 1), cB + hstep, voffB); PG8_STAGE(PG8_SA(0, 0), cA, voffA); PG8_STAGE(PG8_SA(0, 1), cA + hstep, voffA);
        if (wr == 1) PG8_BAR;
        PG8_WAIT_V(2); PG8_BAR;
        PG8_STAGE(PG8_SB(1, 0), cB + kstep, voffB); PG8_STAGE(PG8_SA(1, 0), cA + kstep, voffA); PG8_STAGE(PG8_SB(1, 1), cB + hstep + kstep, voffB);
        PG8_WAIT_V(6); PG8_BAR;
    } else {
        PG8_STAGE(PG8_SB(0, 0), cB, voffB); PG8_STAGE(PG8_SA(0, 0), cA, voffA); PG8_STAGE(PG8_SB(0, 1), cB + hstep, voffB); PG8_STAGE(PG8_SA(0, 1), cA + hstep, voffA);
        if (wr == 1) PG8_BAR;
        PG8_WAIT_V(4); PG8_BAR;
        PG8_STAGE(PG8_SB(1, 0), cB + kstep, voffB); PG8_STAGE(PG8_SA(1, 0), cA + kstep, voffA); PG8_STAGE(PG8_SB(1, 1), cB + hstep + kstep, voffB);
        PG8_WAIT_V(6); PG8_BAR;
    }
    for (;;) {
        const bool has_next = S.next(ui + 1, nxt);
        const char* nA = has_next ? (const char*)g.A + (size_t)nxt.pm * tstep : cA; const char* nB = has_next ? (const char*)g.Bt + (size_t)nxt.pn * tstep : cB;
        for (int t = 0; t < nt; t += 2) {
            const bool last = (t == nt - 2);
            const char* a1 = cA + (size_t)(t + 1) * kstep;
            const char* a2 = last ? nA : cA + (size_t)(t + 2) * kstep; const char* b2 = last ? nB : cB + (size_t)(t + 2) * kstep;
            const char* a3 = a2 + kstep; const char* b3 = b2 + kstep;
            if (last && has_next) S.a_ready(nxt);
            if constexpr (SP2) {
            PG8_LDB(B0, 0, 0); PG8_LDB(B1, 0, 1); PG8_SCHED; PG8_LDA(At, 0, 0); PG8_STAGE(PG8_SA(1, 1), a1 + hstep, voffA);
            PG8_WAIT_V(8); PG8_WAIT_L(0); PG8_BAR; PG8_MMA(0, 0, At, B0); PG8_MMA(0, 1, At, B1); PG8_BAR; PG8_SCHED;
            PG8_LDA(At, 0, 1); PG8_STAGE(PG8_SB(0, 0), b2, voffB); PG8_STAGE(PG8_SB(0, 1), b2 + hstep, voffB); PG8_STAGE(PG8_SA(0, 0), a2, voffA);
            PG8_WAIT_V(8); PG8_WAIT_L(0); PG8_BAR; PG8_MMA(1, 0, At, B0); PG8_MMA(1, 1, At, B1); PG8_BAR; PG8_SCHED;
            PG8_LDB(B0, 1, 0); PG8_LDB(B1, 1, 1); PG8_SCHED; PG8_LDA(At, 1, 0); PG8_STAGE(PG8_SA(0, 1), a2 + hstep, voffA);
            PG8_WAIT_V(8); PG8_WAIT_L(0); PG8_BAR; PG8_MMA(0, 0, At, B0); PG8_MMA(0, 1, At, B1); PG8_BAR; PG8_SCHED;
            PG8_LDA(At, 1, 1); PG8_STAGE(PG8_SB(1, 0), b3, voffB); PG8_STAGE(PG8_SB(1, 1), b3 + hstep, voffB); PG8_STAGE(PG8_SA(1, 0), a3, voffA);
            PG8_WAIT_V(8); PG8_WAIT_L(0); PG8_BAR; PG8_MMA(1, 0, At, B0); PG8_MMA(1, 1, At, B1); PG8_BAR; PG8_SCHED;
            } else {
            PG8_LDB(B0, 0, 0); PG8_SCHED; PG8_LDA(At, 0, 0); PG8_STAGE(PG8_SA(1, 1), a1 + hstep, voffA);
            PG8_WAIT_L(8); PG8_BAR; PG8_WAIT_L(0); PG8_MMA(0, 0, At, B0); PG8_BAR; PG8_SCHED;
            PG8_LDB(B1, 0, 1); PG8_STAGE(PG8_SB(0, 0), b2, voffB);
            PG8_BAR; PG8_WAIT_L(0); PG8_MMA(0, 1, At, B1); PG8_BAR;
            PG8_LDA(At, 0, 1); PG8_STAGE(PG8_SA(0, 0), a2, voffA);
            PG8_BAR; PG8_WAIT_L(0); PG8_MMA(1, 0, At, B0); PG8_BAR; PG8_SCHED;
            PG8_STAGE(PG8_SB(0, 1), b2 + hstep, voffB);
            PG8_WAIT_V(6); PG8_BAR; PG8_MMA(1, 1, At, B1); PG8_BAR;
            PG8_LDB(B0, 1, 0); PG8_SCHED; PG8_LDA(At, 1, 0); PG8_STAGE(PG8_SA(0, 1), a2 + hstep, voffA);
            PG8_WAIT_L(8); PG8_BAR; PG8_WAIT_L(0); PG8_MMA(0, 0, At, B0); PG8_BAR; PG8_SCHED;
            PG8_LDB(B1, 1, 1); PG8_STAGE(PG8_SB(1, 0), b3, voffB);
            PG8_BAR; PG8_WAIT_L(0); PG8_MMA(0, 1, At, B1); PG8_BAR;
            PG8_LDA(At, 1, 1); PG8_STAGE(PG8_SA(1, 0), a3, voffA);
            PG8_BAR; PG8_WAIT_L(0); PG8_MMA(1, 0, At, B0); PG8_BAR; PG8_SCHED;
            PG8_STAGE(PG8_SB(1, 1), b3 + hstep, voffB);
            PG8_WAIT_V(6); PG8_BAR; PG8_MMA(1, 1, At, B1); PG8_BAR;
            }
        }
        if constexpr (ALIGN_EPI) { if (wr == 0) PG8_BAR; }
        if constexpr (!Epi::AFTER_DRAIN) { E(acc, cur, wr, wc, fr, fq); S.done(cur); }
        if (!has_next) break;
#pragma unroll
        for (int a = 0; a < 2; ++a)
#pragma unroll
            for (int b = 0; b < 2; ++b)
#pragma unroll
                for (int m = 0; m < 4; ++m)
#pragma unroll
                    for (int n = 0; n < 2; ++n) acc[a][b][m][n] = (f32x4){0.f, 0.f, 0.f, 0.f};
        cur = nxt; cA = nA; cB = nB; ++ui;
        if constexpr (ALIGN_EPI) { if (wr == 1) PG8_BAR; }
    }
    PG8_WAIT_V(0);
    if constexpr (!ALIGN_EPI) { if (wr == 0) PG8_BAR; }
    PG8_BAR;
    if constexpr (Epi::AFTER_DRAIN) { E.fused(acc, cur, wr, wc, fr, fq, lds, wid, lane); S.done(cur); }
#undef PG8_SA
#undef PG8_SB
#undef PG8_STAGE
#undef PG8_LDA
#undef PG8_LDB
#undef PG8_MMA
#undef PG8_WAIT_V
#undef PG8_WAIT_L
#undef PG8_BAR
#undef PG8_SCHED
}
}
#ifndef PG8_SP2
#define PG8_SP2 true
#endif
#ifndef PG8_ALIGN
#define PG8_ALIGN true
#endif
#ifndef MK_COOP
#define MK_COOP 0
#endif

#define GAS __attribute__((address_space(1)))
#define LAS __attribute__((address_space(3)))
typedef unsigned short bf16;
typedef unsigned v4u __attribute__((ext_vector_type(4)));
typedef unsigned v2u __attribute__((ext_vector_type(2)));
typedef float f32x4 __attribute__((ext_vector_type(4)));
typedef float f32x16 __attribute__((ext_vector_type(16)));
typedef short bf16x8 __attribute__((ext_vector_type(8)));
typedef short s16x4 __attribute__((ext_vector_type(4)));
#define LDS_WAIT() asm volatile("s_waitcnt lgkmcnt(0)" ::: "memory")
__device__ __forceinline__ unsigned pk2(float lo, float hi) { return pg8::cvt_pk_bf16(lo, hi); }
__device__ __forceinline__ float bf_lo(unsigned w) { return __builtin_bit_cast(float, w << 16); }
__device__ __forceinline__ float bf_hi(unsigned w) { return __builtin_bit_cast(float, w & 0xffff0000u); }

constexpr int NWAVES = 8;
constexpr int BATCH = 16, SEQ = 2048, D = 1024, FF = 4096, INW = 2304, M = BATCH * SEQ;
constexpr int NMOD = 6 * D;
constexpr float EPS = 1e-6f;
constexpr int NPH = 10;
constexpr size_t MiB = 1u << 20;
constexpr size_t WS_WIN = 2 * MiB, WS_WOUT = 7 * MiB, WS_WUP = 9 * MiB, WS_WDN = 17 * MiB, WS_MOD = 25 * MiB, WS_ROPE = 26 * MiB, WS_LSE = 28 * MiB;
constexpr size_t WS_XN = 36 * MiB, WS_PROJ = 100 * MiB, WS_MIXED = 244 * MiB, WS_PART = 308 * MiB, WS_H = 100 * MiB, WS_Y = 356 * MiB, WS_END = 484 * MiB;
constexpr int LDS_BYTES = 147456;

struct Frame {
    LAS unsigned char* lds;
    int tid, lane, wave, G;
    const float *x, *c, *w_ada, *b_ada, *g_attn_pre, *g_attn_post, *w_in, *sink_a, *g_mix_a, *g_mix_b, *w_out, *g_mlp_pre, *g_mlp_post, *w_up, *w_down;
    const int* positions;
    float* out;
    bf16 *Win_t, *Wout_t, *Wup_t, *Wdn_t, *XN, *PROJ, *MIXED, *PART, *HB;
    float *MOD, *ROPE, *LSE, *Y;
};

__device__ __forceinline__ float wave_sum(float v) {
#pragma unroll
    for (int o = 1; o < 64; o <<= 1) v += __shfl_xor(v, o);
    return v;
}
__device__ __forceinline__ void p0_transpose_item(const float* W, int K, int N, bf16* WT, LAS float* scr, int item, int lane) {
    const int nblk = N / 32, kb = item / nblk, nb = item % nblk, k0 = 64 * kb, n0 = 32 * nb;
#pragma unroll 8
    for (int i = 0; i < 32; ++i) { const int kk = 2 * i + (lane >> 5); scr[kk * 33 + (lane & 31)] = W[(size_t)(k0 + kk) * N + n0 + (lane & 31)]; }
    LDS_WAIT(); asm volatile("" ::: "memory");
    const int c = lane & 7;
#pragma unroll
    for (int j = 0; j < 4; ++j) { const int n = (lane >> 3) + 8 * j; const LAS float* s = scr + (8 * c) * 33 + n;
        v4u o; o.x = pk2(s[0 * 33], s[1 * 33]); o.y = pk2(s[2 * 33], s[3 * 33]); o.z = pk2(s[4 * 33], s[5 * 33]); o.w = pk2(s[6 * 33], s[7 * 33]);
        *(GAS v4u*)(WT + (size_t)(n0 + n) * K + k0 + 8 * c) = o; }
    LDS_WAIT(); asm volatile("" ::: "memory");
}
__device__ __forceinline__ double inv_freq_d(int i) {
    switch (i) { case 0: return 1.0; case 1: return 0.19392274474868576; case 2: return 0.03760603093086393; case 3: return 0.007292664737217109;
                 case 4: return 0.001414213562373095; case 5: return 0.0002742481756762073; case 6: return 5.318295896944988e-05; default: return 1.031338537721246e-05; }
}
__device__ __forceinline__ void sincos_d(double ang, float& cs, float& sn) {
    const double t = ang * 0.15915494309189535;
    const double fr = t - __builtin_rint(t);
    const double kq = __builtin_rint(fr * 4.0);
    const double y = (fr - kq * 0.25) * 6.283185307179586;
    const double y2 = y * y;
    double s = -1.0 / 1307674368000.0; s = s * y2 + 1.0 / 6227020800.0; s = s * y2 - 1.0 / 39916800.0; s = s * y2 + 1.0 / 362880.0; s = s * y2 - 1.0 / 5040.0; s = s * y2 + 1.0 / 120.0; s = s * y2 - 1.0 / 6.0; s = s * y2 + 1.0; s = s * y;
    double c = 1.0 / 87178291200.0; c = c * y2 - 1.0 / 479001600.0; c = c * y2 + 1.0 / 3628800.0; c = c * y2 - 1.0 / 40320.0; c = c * y2 + 1.0 / 720.0; c = c * y2 - 1.0 / 24.0; c = c * y2 + 0.5; c = 1.0 - c * y2;
    const int k = ((int)kq) & 3;
    double co = c, so = s;
    if (k == 1) { co = -s; so = c; } else if (k == 2) { co = -c; so = -s; } else if (k == 3) { co = s; so = -c; }
    cs = (float)co; sn = (float)so;
}

__device__ __forceinline__ void p0_prologue(Frame& F) {
    if ((int)blockIdx.x < NMOD / 64) {
        LAS float* condT = (LAS float*)F.lds;
        LAS float* red = (LAS float*)(F.lds + 65536);
        for (int idx = F.tid; idx < BATCH * D; idx += NWAVES * 64) { const int b = idx >> 10, k = idx & 1023; const float cv = F.c[idx]; condT[k * 16 + b] = cv / (1.f + __expf(-cv)); }
        __syncthreads();
        for (int it = blockIdx.x; it < NMOD / 64; it += F.G) {
            const int n = it * 64 + F.lane, k0 = F.wave * 128;
            float acc[16];
#pragma unroll
            for (int b = 0; b < 16; ++b) acc[b] = 0.f;
#pragma unroll 4
            for (int k = k0; k < k0 + 128; ++k) {
                const float w = F.w_ada[(size_t)k * NMOD + n];
                const LAS f32x4* cp = (const LAS f32x4*)(condT + k * 16);
#pragma unroll
                for (int q = 0; q < 4; ++q) { const f32x4 cv = cp[q]; acc[4 * q + 0] += cv[0] * w; acc[4 * q + 1] += cv[1] * w; acc[4 * q + 2] += cv[2] * w; acc[4 * q + 3] += cv[3] * w; }
            }
#pragma unroll
            for (int b = 0; b < 16; ++b) red[(F.wave * 16 + b) * 64 + F.lane] = acc[b];
            __syncthreads();
            for (int o = F.tid; o < 1024; o += NWAVES * 64) { const int b = o >> 6, col = o & 63; float s = 0.f;
#pragma unroll
                for (int w = 0; w < 8; ++w) s += red[(w * 16 + b) * 64 + col];
                F.MOD[b * NMOD + it * 64 + col] = s + F.b_ada[it * 64 + col]; }
            __syncthreads();
        }
    }
    __syncthreads();
    LAS float* scr = (LAS float*)(F.lds + F.wave * 16384);
    const int gw = blockIdx.x * NWAVES + F.wave, NGW = F.G * NWAVES;
    constexpr int I_IN = (D / 64) * (INW / 32), I_OUT = (D / 64) * (D / 32), I_UP = (D / 64) * (FF / 32), I_DN = (FF / 64) * (D / 32);
    constexpr int NITEMS = I_IN + I_OUT + I_UP + I_DN;
    for (int it = NGW - 1 - gw; it < NITEMS; it += NGW) {
        int r = it;
        if (r < I_IN) { p0_transpose_item(F.w_in, D, INW, F.Win_t, scr, r, F.lane); continue; } r -= I_IN;
        if (r < I_OUT) { p0_transpose_item(F.w_out, D, D, F.Wout_t, scr, r, F.lane); continue; } r -= I_OUT;
        if (r < I_UP) { p0_transpose_item(F.w_up, D, FF, F.Wup_t, scr, r, F.lane); continue; } r -= I_UP;
        p0_transpose_item(F.w_down, FF, D, F.Wdn_t, scr, r, F.lane);
    }
    for (int idx = blockIdx.x * (NWAVES * 64) + F.tid; idx < M * 8; idx += F.G * NWAVES * 64) {
        const int row = idx >> 3, i = idx & 7;
        const float angf = (float)F.positions[row] * (float)inv_freq_d(i);
        float cs, sn; sincos_d((double)angf, cs, sn);
        F.ROPE[row * 16 + i] = cs; F.ROPE[row * 16 + 8 + i] = sn;
    }
}

__device__ __forceinline__ void p1_prenorm(Frame& F) {
    const int gw = blockIdx.x * NWAVES + F.wave, NGW = F.G * NWAVES;
    for (int m = gw; m < M; m += NGW) {
        const int b = m / SEQ; const float* mod = F.MOD + b * NMOD;
        const f32x4* xr = (const f32x4*)(F.x + (size_t)m * D) + F.lane;
        f32x4 v[4]; float s = 0.f;
#pragma unroll
        for (int j = 0; j < 4; ++j) { v[j] = xr[64 * j]; s += (v[j].x * v[j].x + v[j].y * v[j].y) + (v[j].z * v[j].z + v[j].w * v[j].w); }
        const float rs = 1.0f / sqrtf(wave_sum(s) * (1.f / D) + EPS);
        unsigned long long* o8 = (unsigned long long*)(F.XN + (size_t)m * D) + F.lane;
#pragma unroll
        for (int j = 0; j < 4; ++j) { const int col = 4 * F.lane + 256 * j;
            const f32x4 g = *(const f32x4*)(F.g_attn_pre + col), sh = *(const f32x4*)(mod + col), sc = *(const f32x4*)(mod + D + col);
            const f32x4 h = (v[j] * rs * g) * (sc + 1.f) + sh;
            o8[64 * j] = (unsigned long long)pk2(h.x, h.y) | ((unsigned long long)pk2(h.z, h.w) << 32); }
    }
}
__device__ __forceinline__ void p4_combine(Frame& F) {
    const int gw = blockIdx.x * NWAVES + F.wave, NGW = F.G * NWAVES;
    constexpr size_t PSTR = (size_t)M * 512;
    for (int m = gw; m < M; m += NGW) {
        const size_t off = (size_t)m * 512 + 8 * F.lane;
        const v4u pa = *(const v4u*)(F.PART + off), p1 = *(const v4u*)(F.PART + PSTR + off), p2 = *(const v4u*)(F.PART + 2 * PSTR + off), p3 = *(const v4u*)(F.PART + 3 * PSTR + off);
        const int hd = F.lane >> 3;
        const float l1 = F.LSE[(size_t)m * 8 + hd], l2 = F.LSE[(size_t)M * 8 + (size_t)m * 8 + hd], l3 = F.LSE[(size_t)2 * M * 8 + (size_t)m * 8 + hd];
        const float mx = fmaxf(l1, fmaxf(l2, l3));
        float w1 = __expf(l1 - mx), w2 = __expf(l2 - mx), w3 = __expf(l3 - mx); const float inv = 1.f / (w1 + w2 + w3); w1 *= inv; w2 *= inv; w3 *= inv;
        float oa[8], ob[8]; float sa = 0.f, sb = 0.f;
#pragma unroll
        for (int q = 0; q < 4; ++q) {
            oa[2 * q] = bf_lo(pa[q]); oa[2 * q + 1] = bf_hi(pa[q]);
            ob[2 * q] = w1 * bf_lo(p1[q]) + w2 * bf_lo(p2[q]) + w3 * bf_lo(p3[q]); ob[2 * q + 1] = w1 * bf_hi(p1[q]) + w2 * bf_hi(p2[q]) + w3 * bf_hi(p3[q]);
            sa += oa[2 * q] * oa[2 * q] + oa[2 * q + 1] * oa[2 * q + 1]; sb += ob[2 * q] * ob[2 * q] + ob[2 * q + 1] * ob[2 * q + 1]; }
        const float ra = 1.0f / sqrtf(wave_sum(sa) * (1.f / 512.f) + EPS), rb = 1.0f / sqrtf(wave_sum(sb) * (1.f / 512.f) + EPS);
        const f32x4 ga0 = *(const f32x4*)(F.g_mix_a + 8 * F.lane), ga1 = *(const f32x4*)(F.g_mix_a + 8 * F.lane + 4), gb0 = *(const f32x4*)(F.g_mix_b + 8 * F.lane), gb1 = *(const f32x4*)(F.g_mix_b + 8 * F.lane + 4);
        v4u wa, wb;
        wa.x = pk2(oa[0] * ra * ga0[0], oa[1] * ra * ga0[1]); wa.y = pk2(oa[2] * ra * ga0[2], oa[3] * ra * ga0[3]); wa.z = pk2(oa[4] * ra * ga1[0], oa[5] * ra * ga1[1]); wa.w = pk2(oa[6] * ra * ga1[2], oa[7] * ra * ga1[3]);
        wb.x = pk2(ob[0] * rb * gb0[0], ob[1] * rb * gb0[1]); wb.y = pk2(ob[2] * rb * gb0[2], ob[3] * rb * gb0[3]); wb.z = pk2(ob[4] * rb * gb1[0], ob[5] * rb * gb1[1]); wb.w = pk2(ob[6] * rb * gb1[2], ob[7] * rb * gb1[3]);
        *(v4u*)(F.MIXED + (size_t)m * D + 8 * F.lane) = wa; *(v4u*)(F.MIXED + (size_t)m * D + 512 + 8 * F.lane) = wb;
    }
}
__device__ __forceinline__ void p6_mid(Frame& F) {
    const int gw = blockIdx.x * NWAVES + F.wave, NGW = F.G * NWAVES;
    for (int m = gw; m < M; m += NGW) {
        const int b = m / SEQ; const float* mod = F.MOD + b * NMOD;
        const f32x4* yr = (const f32x4*)(F.Y + (size_t)m * D) + F.lane; const f32x4* xr = (const f32x4*)(F.x + (size_t)m * D) + F.lane;
        f32x4 v[4], xv[4]; float s = 0.f;
#pragma unroll
        for (int j = 0; j < 4; ++j) { v[j] = yr[64 * j]; xv[j] = xr[64 * j]; s += (v[j].x * v[j].x + v[j].y * v[j].y) + (v[j].z * v[j].z + v[j].w * v[j].w); }
        const float rs = 1.0f / sqrtf(wave_sum(s) * (1.f / D) + EPS);
        float s2 = 0.f; f32x4* orow = (f32x4*)(F.out + (size_t)m * D) + F.lane;
#pragma unroll
        for (int j = 0; j < 4; ++j) { const int col = 4 * F.lane + 256 * j;
            const f32x4 g = *(const f32x4*)(F.g_attn_post + col), gt = *(const f32x4*)(mod + 2 * D + col);
            xv[j] = xv[j] + gt * (v[j] * rs * g); orow[64 * j] = xv[j];
            s2 += (xv[j].x * xv[j].x + xv[j].y * xv[j].y) + (xv[j].z * xv[j].z + xv[j].w * xv[j].w); }
        const float rs2 = 1.0f / sqrtf(wave_sum(s2) * (1.f / D) + EPS);
        unsigned long long* o8 = (unsigned long long*)(F.XN + (size_t)m * D) + F.lane;
#pragma unroll
        for (int j = 0; j < 4; ++j) { const int col = 4 * F.lane + 256 * j;
            const f32x4 g = *(const f32x4*)(F.g_mlp_pre + col), sh = *(const f32x4*)(mod + 3 * D + col), sc = *(const f32x4*)(mod + 4 * D + col);
            const f32x4 h = (xv[j] * rs2 * g) * (sc + 1.f) + sh;
            o8[64 * j] = (unsigned long long)pk2(h.x, h.y) | ((unsigned long long)pk2(h.z, h.w) << 32); }
    }
}
__device__ __forceinline__ void p9_final(Frame& F) {
    const int gw = blockIdx.x * NWAVES + F.wave, NGW = F.G * NWAVES;
    for (int m = gw; m < M; m += NGW) {
        const int b = m / SEQ; const float* mod = F.MOD + b * NMOD;
        const f32x4* yr = (const f32x4*)(F.Y + (size_t)m * D) + F.lane; f32x4* orow = (f32x4*)(F.out + (size_t)m * D) + F.lane;
        f32x4 v[4], xv[4]; float s = 0.f;
#pragma unroll
        for (int j = 0; j < 4; ++j) { v[j] = yr[64 * j]; xv[j] = orow[64 * j]; s += (v[j].x * v[j].x + v[j].y * v[j].y) + (v[j].z * v[j].z + v[j].w * v[j].w); }
        const float rs = 1.0f / sqrtf(wave_sum(s) * (1.f / D) + EPS);
#pragma unroll
        for (int j = 0; j < 4; ++j) { const int col = 4 * F.lane + 256 * j;
            const f32x4 g = *(const f32x4*)(F.g_mlp_post + col), gt = *(const f32x4*)(mod + 5 * D + col);
            orow[64 * j] = xv[j] + gt * (v[j] * rs * g); }
    }
}

constexpr int VROW = 192;
constexpr float SC2 = 0.125f * 1.4426950408889634f;
typedef short v4i16_t __attribute__((ext_vector_type(4)));
__device__ __forceinline__ s16x4 vtr(const LAS unsigned char* p) { return __builtin_bit_cast(s16x4, __builtin_amdgcn_ds_read_tr16_b64_v4i16((LAS v4i16_t*)p)); }

__device__ __forceinline__ void attn_job(Frame& F, int job) {
    const int lane = F.lane, h = F.wave, q = lane & 31, hi = lane >> 5;
    const int br = job >> 10, rem = job & 1023, b = rem >> 6, tt = rem & 63;
    const int dsh = br < 2 ? 0 : (br == 2 ? 2 : 4), d = 1 << dsh;
    const int r = tt >> (6 - dsh), it = tt & ((64 >> dsh) - 1), i0 = it * 32;
    const int qcol = br == 0 ? h * 64 : 768 + h * 64, kcol = br == 0 ? 512 + (h >> 2) * 64 : 1280 + h * 64, vcol = br == 0 ? 640 + (h >> 2) * 64 : 1792 + h * 64;
    const int maxd = br == 0 ? 127 : 128;
    const size_t rowbase = (size_t)b * SEQ + r;
    LAS unsigned char* vl = F.lds + h * (32 * VROW);
    const bf16* P = F.PROJ;
    bf16x8 qf[4];
    { const bf16* qp = P + (rowbase + (size_t)d * (i0 + q)) * INW + qcol + 8 * hi;
#pragma unroll
      for (int kd = 0; kd < 4; ++kd) qf[kd] = *(const bf16x8*)(qp + 16 * kd); }
    float mrun = br == 0 ? F.sink_a[h] * 8.0f : -5e29f, lrun = br == 0 ? 1.f : 0.f;
    f32x16 O0, O1;
#pragma unroll
    for (int i = 0; i < 16; ++i) { O0[i] = 0.f; O1[i] = 0.f; }
    const int iq = i0 + q; const unsigned lim = (unsigned)(iq < maxd ? iq : maxd);
    const LAS unsigned char* trb = vl + (4 * hi + ((lane & 15) >> 2)) * VROW + (16 * ((lane >> 4) & 1) + 4 * (lane & 3)) * 2;
    for (int kt = 0; kt < 5; ++kt) {
        const int j0 = i0 - 128 + 32 * kt;
        if (j0 + 31 < 0) continue;
        bf16x8 kf[4];
        { int jk = j0 + q; jk = jk < 0 ? 0 : jk; const bf16* kp = P + (rowbase + (size_t)d * jk) * INW + kcol + 8 * hi;
#pragma unroll
          for (int kd = 0; kd < 4; ++kd) kf[kd] = *(const bf16x8*)(kp + 16 * kd); }
        v4u vr[4];
#pragma unroll
        for (int i = 0; i < 4; ++i) { int jv = j0 + (lane >> 3) + 8 * i; jv = jv < 0 ? 0 : jv; vr[i] = *(const v4u*)(P + (rowbase + (size_t)d * jv) * INW + vcol + 8 * (lane & 7)); }
        f32x16 S;
#pragma unroll
        for (int i = 0; i < 16; ++i) S[i] = 0.f;
#pragma unroll
        for (int kd = 0; kd < 4; ++kd) S = __builtin_amdgcn_mfma_f32_32x32x16_bf16(kf[kd], qf[kd], S, 0, 0, 0);
        const int dl0 = iq - j0 - 4 * hi;
        float mx = -1e30f;
#pragma unroll
        for (int i = 0; i < 16; ++i) { const unsigned dl = (unsigned)(dl0 - (8 * (i >> 2) + (i & 3))); S[i] = dl <= lim ? S[i] : -1e30f; mx = fmaxf(mx, S[i]); }
        mx = fmaxf(mx, __shfl_xor(mx, 32));
        const float mnew = fmaxf(mrun, mx), alpha = __builtin_amdgcn_exp2f((mrun - mnew) * SC2), nb = -mnew * SC2;
        float rsum = 0.f;
#pragma unroll
        for (int i = 0; i < 16; ++i) { S[i] = __builtin_amdgcn_exp2f(__builtin_fmaf(S[i], SC2, nb)); rsum += S[i]; }
        rsum += __shfl_xor(rsum, 32);
        lrun = lrun * alpha + rsum; mrun = mnew;
#pragma unroll
        for (int i = 0; i < 16; ++i) { O0[i] *= alpha; O1[i] *= alpha; }
        asm volatile("" ::: "memory");
#pragma unroll
        for (int i = 0; i < 4; ++i) *(LAS v4u*)(vl + ((lane >> 3) + 8 * i) * VROW + (lane & 7) * 16) = vr[i];
        asm volatile("s_waitcnt lgkmcnt(0)" ::: "memory");
#pragma unroll
        for (int kk = 0; kk < 2; ++kk) {
            v4u pw; pw.x = pk2(S[8 * kk + 0], S[8 * kk + 1]); pw.y = pk2(S[8 * kk + 2], S[8 * kk + 3]); pw.z = pk2(S[8 * kk + 4], S[8 * kk + 5]); pw.w = pk2(S[8 * kk + 6], S[8 * kk + 7]);
            const bf16x8 pb = __builtin_bit_cast(bf16x8, pw);
            { const s16x4 lo = vtr(trb + kk * 16 * VROW), up = vtr(trb + kk * 16 * VROW + 8 * VROW);
              const bf16x8 va = {lo[0], lo[1], lo[2], lo[3], up[0], up[1], up[2], up[3]};
              O0 = __builtin_amdgcn_mfma_f32_32x32x16_bf16(va, pb, O0, 0, 0, 0); }
            { const s16x4 lo = vtr(trb + kk * 16 * VROW + 64), up = vtr(trb + kk * 16 * VROW + 8 * VROW + 64);
              const bf16x8 va = {lo[0], lo[1], lo[2], lo[3], up[0], up[1], up[2], up[3]};
              O1 = __builtin_amdgcn_mfma_f32_32x32x16_bf16(va, pb, O1, 0, 0, 0); }
        }
        asm volatile("s_waitcnt lgkmcnt(0)" ::: "memory");
    }
    const float invl = 1.f / lrun;
    const size_t orow = rowbase + (size_t)d * iq;
    bf16* op = F.PART + (size_t)br * M * 512 + orow * 512 + h * 64 + 4 * hi;
#pragma unroll
    for (int g = 0; g < 4; ++g) {
        v2u w0, w1; w0.x = pk2(O0[4 * g] * invl, O0[4 * g + 1] * invl); w0.y = pk2(O0[4 * g + 2] * invl, O0[4 * g + 3] * invl);
        w1.x = pk2(O1[4 * g] * invl, O1[4 * g + 1] * invl); w1.y = pk2(O1[4 * g + 2] * invl, O1[4 * g + 3] * invl);
        *(v2u*)(op + 8 * g) = w0; *(v2u*)(op + 32 + 8 * g) = w1; }
    if (br > 0 && hi == 0) F.LSE[(size_t)(br - 1) * M * 8 + orow * 8 + h] = mrun * 0.125f + __logf(lrun);
}

struct Args { const void* in[16]; float* out; unsigned char* ws; int ph_lo, ph_hi; };
__global__ void __launch_bounds__(NWAVES * 64, 2) fwd_kernel(Args args) {
    extern __shared__ __attribute__((aligned(16))) unsigned char lds[];
    cooperative_groups::grid_group grid = cooperative_groups::this_grid();
    Frame F;
    F.lds = (LAS unsigned char*)lds;
    F.tid = threadIdx.x; F.lane = F.tid & 63; F.wave = __builtin_amdgcn_readfirstlane(F.tid >> 6); F.G = gridDim.x;
    unsigned char* ws = args.ws;
    F.x = (const float*)args.in[0]; F.c = (const float*)args.in[1]; F.positions = (const int*)args.in[2]; F.w_ada = (const float*)args.in[3]; F.b_ada = (const float*)args.in[4];
    F.g_attn_pre = (const float*)args.in[5]; F.g_attn_post = (const float*)args.in[6]; F.w_in = (const float*)args.in[7]; F.sink_a = (const float*)args.in[8];
    F.g_mix_a = (const float*)args.in[9]; F.g_mix_b = (const float*)args.in[10]; F.w_out = (const float*)args.in[11]; F.g_mlp_pre = (const float*)args.in[12]; F.g_mlp_post = (const float*)args.in[13];
    F.w_up = (const float*)args.in[14]; F.w_down = (const float*)args.in[15]; F.out = args.out;
    F.Win_t = (bf16*)(ws + WS_WIN); F.Wout_t = (bf16*)(ws + WS_WOUT); F.Wup_t = (bf16*)(ws + WS_WUP); F.Wdn_t = (bf16*)(ws + WS_WDN);
    F.MOD = (float*)(ws + WS_MOD); F.ROPE = (float*)(ws + WS_ROPE); F.LSE = (float*)(ws + WS_LSE);
    F.XN = (bf16*)(ws + WS_XN); F.PROJ = (bf16*)(ws + WS_PROJ); F.MIXED = (bf16*)(ws + WS_MIXED); F.PART = (bf16*)(ws + WS_PART); F.HB = (bf16*)(ws + WS_H); F.Y = (float*)(ws + WS_Y);
    const int lo = args.ph_lo, hi = args.ph_hi;
#define IN(k) (lo <= (k) && (k) < hi)
#define SEAM(k) do { if (IN(k) && IN((k) + 1)) grid.sync(); } while (0)

    if (IN(0)) { p0_prologue(F); } SEAM(0);
    if (IN(1)) { p1_prenorm(F); } SEAM(1);
    if (IN(2)) {
        pg8::Gemm g{F.XN, F.Win_t, M, INW, D}; pg8::StaticOrder S; S.init(M, INW, F.G, (int)blockIdx.x);
        pg8::EpiProj E{F.PROJ, INW, F.ROPE};
        pg8::gemm_phase<pg8::EpiProj, pg8::StaticOrder, PG8_ALIGN, PG8_SP2>(F.lds, g, S, E);
    } SEAM(2);
    if (IN(3)) { for (int job = blockIdx.x; job < 4096; job += F.G) attn_job(F, job); } SEAM(3);
    if (IN(4)) { p4_combine(F); } SEAM(4);
    if (IN(5)) {
        pg8::Gemm g{F.MIXED, F.Wout_t, M, D, D}; pg8::StaticOrder S; S.init(M, D, F.G, (int)blockIdx.x);
        pg8::EpiF32 E{F.Y, D};
        pg8::gemm_phase<pg8::EpiF32, pg8::StaticOrder, PG8_ALIGN, PG8_SP2>(F.lds, g, S, E);
    } SEAM(5);
    if (IN(6)) { p6_mid(F); } SEAM(6);
    if (IN(7)) {
        pg8::Gemm g{F.XN, F.Wup_t, M, FF, D}; pg8::StaticOrder S; S.init(M, FF, F.G, (int)blockIdx.x);
        pg8::EpiSqRelu E{F.HB, FF};
        pg8::gemm_phase<pg8::EpiSqRelu, pg8::StaticOrder, PG8_ALIGN, PG8_SP2>(F.lds, g, S, E);
    } SEAM(7);
    if (IN(8)) {
        pg8::Gemm g{F.HB, F.Wdn_t, M, D, FF}; pg8::StaticOrder S; S.init(M, D, F.G, (int)blockIdx.x);
        pg8::EpiF32 E{F.Y, D};
        pg8::gemm_phase<pg8::EpiF32, pg8::StaticOrder, PG8_ALIGN, PG8_SP2>(F.lds, g, S, E);
    } SEAM(8);
    if (IN(9)) { p9_final(F); }
#undef IN
#undef SEAM
}

extern "C" void kernel_launch(void* const* d_in, const int* in_sizes, int n_in, void* d_out, int out_size, void* d_ws, size_t ws_size, hipStream_t stream) {
    static int grid = 0;
    if (grid == 0) {
        if (n_in != 16 || in_sizes[0] != M * D || out_size != M * D || ws_size < WS_END) { fprintf(stderr, "kernel_launch: unexpected shapes (n_in %d, in0 %d, out %d, ws %zu); nothing launched\n", n_in, n_in > 0 ? in_sizes[0] : -1, out_size, ws_size); grid = -1; return; }
        int dev = 0, cus = 0, per_cu = 0;
        if (hipGetDevice(&dev) != hipSuccess || hipDeviceGetAttribute(&cus, hipDeviceAttributeMultiprocessorCount, dev) != hipSuccess) { grid = -1; return; }
        if (hipFuncSetAttribute((const void*)fwd_kernel, hipFuncAttributeMaxDynamicSharedMemorySize, LDS_BYTES) != hipSuccess) { fprintf(stderr, "kernel_launch: hipFuncSetAttribute failed\n"); grid = -1; return; }
        if (hipOccupancyMaxActiveBlocksPerMultiprocessor(&per_cu, (const void*)fwd_kernel, NWAVES * 64, LDS_BYTES) != hipSuccess || per_cu < 1) { fprintf(stderr, "kernel_launch: occupancy query says %d\n", per_cu); per_cu = 1; }
        (void)hipGetLastError();
        grid = cus * per_cu;
    }
    if (grid < 0) return;
    Args a{};
    for (int i = 0; i < 16; ++i) a.in[i] = d_in[i];
    a.out = (float*)d_out; a.ws = (unsigned char*)d_ws;
#if MK_COOP
    a.ph_lo = 0; a.ph_hi = NPH;
    void* kargs[] = {&a};
    hipError_t e = hipLaunchCooperativeKernel((const void*)fwd_kernel, dim3(grid), dim3(NWAVES * 64), kargs, LDS_BYTES, stream);
    if (e != hipSuccess) fprintf(stderr, "kernel_launch: cooperative launch failed: %s (grid %d)\n", hipGetErrorString(e), grid);
#else
    for (int ph = 0; ph < NPH; ++ph) { a.ph_lo = ph; a.ph_hi = ph + 1; hipLaunchKernelGGL(fwd_kernel, dim3(grid), dim3(NWAVES * 64), LDS_BYTES, stream, a); }
#endif
}
```

```cpp
#include <hip/hip_cooperative_groups.h>
#include <hip/hip_runtime.h>
#include <cstdio>
#include <cstdint>
namespace pg8 {
#define PG8_LAS __attribute__((address_space(3)))
typedef unsigned short bf16_t;
typedef short bf16x8 __attribute__((ext_vector_type(8)));
typedef float f32x4 __attribute__((ext_vector_type(4)));
typedef unsigned u32x4 __attribute__((ext_vector_type(4)));
constexpr int BM = 256, BK = 64, HALF = 128, HTB = HALF * BK * 2  , STAGE_BYTES = 8 * HTB, NXCD = 8, WGM = 8;

__host__ __device__ __forceinline__ int lds_byte(int r, int c) { const int st = (r >> 4) * 2 + (c >> 5), rr = r & 15, cc = c & 31, ob = rr * 64 + cc * 2; return st * 1024 + (ob ^ (((ob >> 9) & 1) << 5)); }
__host__ __device__ __forceinline__ void stage_rc(int b, int& R, int& C) { const int st = b / 1024, sb = b % 1024, swz = sb ^ (((sb >> 9) & 1) << 5); R = (st >> 1) * 16 + swz / 64; C = (st & 1) * 32 + (swz % 64) / 2; }
__host__ __device__ __forceinline__ int perm32(int rho) { const int n = rho >> 4, i = rho & 15; return 8 * (i >> 2) + 4 * n + (i & 3); }

struct Unit { int pm, pn; };
struct Gemm { const bf16_t* A; const bf16_t* Bt; int M, N, K; };

struct StaticOrder {
    int nM, nN, nwg, G, c;
    __host__ __device__ void init(int M, int N, int G_, int c_) { nM = M / BM; nN = N / BM; nwg = nM * nN; G = G_; c = c_; }
    __host__ __device__ bool next(int i, Unit& u) const {
        const long L = (long)i * G + c; if (L >= nwg) return false;
        int wgid = (int)L; { const int q = nwg / NXCD, r = nwg % NXCD, xcd = wgid % NXCD, off = wgid / NXCD; wgid = (xcd < r ? xcd * (q + 1) : r * (q + 1) + (xcd - r) * q) + off; }
        const int nig = WGM * nN, gid = wgid / nig, fm = gid * WGM, gsz = (nM - fm) < WGM ? (nM - fm) : WGM;
        u.pm = fm + ((wgid % nig) % gsz); u.pn = (wgid % nig) / gsz; return true;
    }
    __device__ __forceinline__ void a_ready(const Unit&) const {}
    __device__ __forceinline__ void done(const Unit&) const {}
};

__device__ __forceinline__ unsigned cvt_pk_bf16(float lo, float hi) { unsigned r; asm volatile("v_cvt_pk_bf16_f32 %0, %1, %2" : "=v"(r) : "v"(lo), "v"(hi)); return r; }
typedef float f32x2 __attribute__((ext_vector_type(2)));
__device__ __forceinline__ f32x2 gelu_pk(f32x2 v) {
    const f32x2 av = __builtin_elementwise_abs(v), d = av * 0.2316418882f + 1.0f;
    f32x2 t; t.x = __builtin_amdgcn_rcpf(d.x); t.y = __builtin_amdgcn_rcpf(d.y);
    f32x2 q = t * 0.5307027145f + (-0.7265760135f); q = q * t + 0.7107068705f; q = q * t + (-0.142248368f); q = q * t + 0.127414796f; q = q * t;
    const f32x2 s = (v * v) * (-0.72134752044f);
    f32x2 e; e.x = __builtin_amdgcn_exp2f(s.x); e.y = __builtin_amdgcn_exp2f(s.y);
    const f32x2 m = v * (q * e), r = v - m;
    f32x2 o; o.x = v.x < 0.f ? m.x : r.x; o.y = v.y < 0.f ? m.y : r.y; return o;
}

template <int ACT  > struct EpiBf16 {
    static constexpr bool PERM = true, AFTER_DRAIN = false; static_assert(ACT == 0 || ACT == 1, "EpiBf16: ACT is 0 (none) or 1 (gelu_pk)");
    bf16_t* O; int ldc; const float* bias; int split_cols; size_t split_stride; float scale0;
    __device__ __forceinline__ void operator()(const f32x4 (&acc)[2][2][4][2], const Unit& u, int wr, int wc, int fr, int fq) const {
        const int row0 = u.pm * BM + wr * 64 + fr; int colt = u.pn * BM; bf16_t* base = O;
        float sc = 1.f; if (split_cols) { const int t = colt / split_cols; base += (size_t)t * split_stride; colt -= t * split_cols; if (t == 0) sc = scale0; }
        const int col0 = colt + wc * 32 + 8 * fq, bcol0 = u.pn * BM + wc * 32 + 8 * fq;
        f32x4 bv[2][2];
#pragma unroll
        for (int bj = 0; bj < 2; ++bj)
#pragma unroll
            for (int n = 0; n < 2; ++n) bv[bj][n] = bias ? *(const f32x4*)(bias + bcol0 + bj * HALF + 4 * n) : (f32x4){0.f, 0.f, 0.f, 0.f};
#pragma unroll
        for (int ai = 0; ai < 2; ++ai)
#pragma unroll
            for (int m = 0; m < 4; ++m) { bf16_t* rowp = base + (size_t)(row0 + ai * HALF + m * 16) * ldc + col0;
#pragma unroll
                for (int bj = 0; bj < 2; ++bj) { f32x4 v0 = acc[ai][bj][m][0] + bv[bj][0], v1 = acc[ai][bj][m][1] + bv[bj][1];
                    if (ACT == 1) { f32x2 a = gelu_pk((f32x2){v0[0], v0[1]}), b = gelu_pk((f32x2){v0[2], v0[3]}), c = gelu_pk((f32x2){v1[0], v1[1]}), d = gelu_pk((f32x2){v1[2], v1[3]});
                        v0 = (f32x4){a.x, a.y, b.x, b.y}; v1 = (f32x4){c.x, c.y, d.x, d.y}; }
                    v0 = v0 * sc; v1 = v1 * sc; u32x4 w; w.x = cvt_pk_bf16(v0[0], v0[1]); w.y = cvt_pk_bf16(v0[2], v0[3]); w.z = cvt_pk_bf16(v1[0], v1[1]); w.w = cvt_pk_bf16(v1[2], v1[3]);
                    *(u32x4*)(rowp + bj * HALF) = w; } }
    }
};

struct EpiProj {
    static constexpr bool PERM = true, AFTER_DRAIN = false;
    bf16_t* O; int ldc; const float* rope;
    __device__ __forceinline__ void operator()(const f32x4 (&acc)[2][2][4][2], const Unit& u, int wr, int wc, int fr, int fq) const {
        const int row0 = u.pm * BM + wr * 64 + fr; const int colt = u.pn * BM; const int col0 = colt + wc * 32 + 8 * fq;
        const bool wrot = (wc & 1) == 0;
        const float sgn = (fq == 0) ? -1.f : 1.f;
#pragma unroll
        for (int ai = 0; ai < 2; ++ai)
#pragma unroll
            for (int m = 0; m < 4; ++m) {
                const int row = row0 + ai * HALF + m * 16;
                bf16_t* rowp = O + ((size_t)(col0 >> 6) * 32768 + row) * 64 + (col0 & 63);
                f32x4 c0v = {1.f, 1.f, 1.f, 1.f}, c1v = c0v, s0v = {0.f, 0.f, 0.f, 0.f}, s1v = s0v;
                if (wrot) { const f32x4* rp = (const f32x4*)(rope + (size_t)row * 16); c0v = rp[0]; c1v = rp[1]; s0v = rp[2] * sgn; s1v = rp[3] * sgn; }
#pragma unroll
                for (int bj = 0; bj < 2; ++bj) {
                    f32x4 v0 = acc[ai][bj][m][0], v1 = acc[ai][bj][m][1];
                    const int cb = colt + bj * HALF;
                    const bool rot = wrot && (cb < 640 || (cb >= 768 && cb < 1792));
                    if (rot) {
                        f32x4 p0, p1;
#pragma unroll
                        for (int j = 0; j < 4; ++j) { p0[j] = __shfl_xor(v0[j], 16); p1[j] = __shfl_xor(v1[j], 16); }
                        if (fq < 2) { v0 = v0 * c0v + p0 * s0v; v1 = v1 * c1v + p1 * s1v; }
                    }
                    u32x4 w; w.x = cvt_pk_bf16(v0[0], v0[1]); w.y = cvt_pk_bf16(v0[2], v0[3]); w.z = cvt_pk_bf16(v1[0], v1[1]); w.w = cvt_pk_bf16(v1[2], v1[3]);
                    *(u32x4*)(rowp + (size_t)bj * 2 * 32768 * 64) = w;
                }
            }
    }
};
struct EpiSqRelu {
    static constexpr bool PERM = true, AFTER_DRAIN = false;
    bf16_t* O; int ldc;
    __device__ __forceinline__ void operator()(const f32x4 (&acc)[2][2][4][2], const Unit& u, int wr, int wc, int fr, int fq) const {
        const int row0 = u.pm * BM + wr * 64 + fr; const int col0 = u.pn * BM + wc * 32 + 8 * fq;
#pragma unroll
        for (int ai = 0; ai < 2; ++ai)
#pragma unroll
            for (int m = 0; m < 4; ++m) { bf16_t* rowp = O + (size_t)(row0 + ai * HALF + m * 16) * ldc + col0;
#pragma unroll
                for (int bj = 0; bj < 2; ++bj) { f32x4 v0 = acc[ai][bj][m][0], v1 = acc[ai][bj][m][1];
                    v0 = __builtin_elementwise_max(v0, (f32x4){0.f, 0.f, 0.f, 0.f}); v1 = __builtin_elementwise_max(v1, (f32x4){0.f, 0.f, 0.f, 0.f}); v0 = v0 * v0; v1 = v1 * v1;
                    u32x4 w; w.x = cvt_pk_bf16(v0[0], v0[1]); w.y = cvt_pk_bf16(v0[2], v0[3]); w.z = cvt_pk_bf16(v1[0], v1[1]); w.w = cvt_pk_bf16(v1[2], v1[3]);
                    *(u32x4*)(rowp + bj * HALF) = w; } }
    }
};
struct EpiBf {
    static constexpr bool PERM = true, AFTER_DRAIN = false;
    bf16_t* O; int ldc;
    __device__ __forceinline__ void operator()(const f32x4 (&acc)[2][2][4][2], const Unit& u, int wr, int wc, int fr, int fq) const {
        const int row0 = u.pm * BM + wr * 64 + fr; const int col0 = u.pn * BM + wc * 32 + 8 * fq;
#pragma unroll
        for (int ai = 0; ai < 2; ++ai)
#pragma unroll
            for (int m = 0; m < 4; ++m) { bf16_t* rowp = O + (size_t)(row0 + ai * HALF + m * 16) * ldc + col0;
#pragma unroll
                for (int bj = 0; bj < 2; ++bj) { const f32x4 v0 = acc[ai][bj][m][0], v1 = acc[ai][bj][m][1];
                    u32x4 w; w.x = cvt_pk_bf16(v0[0], v0[1]); w.y = cvt_pk_bf16(v0[2], v0[3]); w.z = cvt_pk_bf16(v1[0], v1[1]); w.w = cvt_pk_bf16(v1[2], v1[3]);
                    *(u32x4*)(rowp + bj * HALF) = w; } }
    }
};
struct EpiF32 {
    static constexpr bool PERM = true, AFTER_DRAIN = false;
    float* O; int ldc;
    __device__ __forceinline__ void operator()(const f32x4 (&acc)[2][2][4][2], const Unit& u, int wr, int wc, int fr, int fq) const {
        const int row0 = u.pm * BM + wr * 64 + fr; const int col0 = u.pn * BM + wc * 32 + 8 * fq;
#pragma unroll
        for (int ai = 0; ai < 2; ++ai)
#pragma unroll
            for (int m = 0; m < 4; ++m) { float* rowp = O + (size_t)(row0 + ai * HALF + m * 16) * ldc + col0;
#pragma unroll
                for (int bj = 0; bj < 2; ++bj) { *(f32x4*)(rowp + bj * HALF) = acc[ai][bj][m][0]; *(f32x4*)(rowp + bj * HALF + 4) = acc[ai][bj][m][1]; } }
    }
};
template <class Epi, class Sched, bool ALIGN_EPI = false, bool SP2 = false>
__device__ __forceinline__ void gemm_phase(PG8_LAS unsigned char* lds, const Gemm g, const Sched& S, const Epi& E) {
    const int tid = threadIdx.x, wid = __builtin_amdgcn_readfirstlane(tid >> 6), lane = tid & 63, wr = wid >> 2, wc = wid & 3, fr = lane & 15, fq = lane >> 4;
    const int K = g.K, nt = K / BK;
    unsigned voffA[2], voffB[2];
#pragma unroll
    for (int i = 0; i < 2; ++i) { int R, C; stage_rc(tid * 16 + i * 8192, R, C); const int Rb = Epi::PERM ? ((R & ~31) + perm32(R & 31)) : R;
        voffA[i] = (unsigned)(R * K + C) * 2u; voffB[i] = (unsigned)(Rb * K + C) * 2u; }
    const size_t kstep = (size_t)(BK * 2);
    const size_t hstep = (size_t)HALF * K * 2;
    const size_t tstep = 2 * hstep;
    const unsigned ldsw = (unsigned)wid * 1024u;
    const int aoff = lds_byte(wr * 64 + fr, fq * 8), boff = lds_byte(wc * 32 + fr, fq * 8);
#define PG8_SA(b, h) (((b) * 2 + (h)) * HTB)
#define PG8_SB(b, h) ((4 + (b) * 2 + (h)) * HTB)
#define PG8_STAGE(bufoff, gbase, voff) do { _Pragma("unroll") for (int _i = 0; _i < 2; ++_i) \
        __builtin_amdgcn_global_load_lds((const unsigned*)((const char*)(gbase) + (voff)[_i]), (PG8_LAS unsigned*)(lds + (bufoff) + ldsw + _i * 8192), 16, 0, 0); } while (0)
#define PG8_LDA(dst, b, h) do { _Pragma("unroll") for (int m = 0; m < 4; ++m) _Pragma("unroll") for (int k = 0; k < 2; ++k) dst[m][k] = *(const PG8_LAS bf16x8*)(lds + PG8_SA(b, h) + aoff + m * 2048 + k * 1024); } while (0)
#define PG8_LDB(dst, b, h) do { _Pragma("unroll") for (int n = 0; n < 2; ++n) _Pragma("unroll") for (int k = 0; k < 2; ++k) dst[n][k] = *(const PG8_LAS bf16x8*)(lds + PG8_SB(b, h) + boff + n * 2048 + k * 1024); } while (0)
#define PG8_MMA(ai, bj, At, Bt) do { __builtin_amdgcn_s_setprio(1); _Pragma("unroll") for (int m = 0; m < 4; ++m) _Pragma("unroll") for (int n = 0; n < 2; ++n) _Pragma("unroll") for (int k = 0; k < 2; ++k) \
        acc[ai][bj][m][n] = __builtin_amdgcn_mfma_f32_16x16x32_bf16(Bt[n][k], At[m][k], acc[ai][bj][m][n], 0, 0, 0); __builtin_amdgcn_s_setprio(0); } while (0)
#define PG8_WAIT_V(n) asm volatile("s_waitcnt vmcnt(" #n ")" ::: "memory")
#define PG8_WAIT_L(n) asm volatile("s_waitcnt lgkmcnt(" #n ")" ::: "memory")
#define PG8_BAR __builtin_amdgcn_s_barrier()
#define PG8_SCHED __builtin_amdgcn_sched_barrier(0)
    Unit cur, nxt; int ui = 0;
    if (!S.next(0, cur)) return;
    f32x4 acc[2][2][4][2];
#pragma unroll
    for (int a = 0; a < 2; ++a)
#pragma unroll
        for (int b = 0; b < 2; ++b)
#pragma unroll
            for (int m = 0; m < 4; ++m)
#pragma unroll
                for (int n = 0; n < 2; ++n) acc[a][b][m][n] = (f32x4){0.f, 0.f, 0.f, 0.f};
    bf16x8 At[4][2], B0[2][2], B1[2][2];
    const char* cA = (const char*)g.A + (size_t)cur.pm * tstep; const char* cB = (const char*)g.Bt + (size_t)cur.pn * tstep;
    S.a_ready(cur);
    if constexpr (SP2) {
        PG8_STAGE(PG8_SB(0, 0), cB, voffB); PG8_STAGE(PG8_SB(0, 1), cB + hstep, voffB); PG8_STAGE(PG8_SA(0, 0), cA, voffA); PG8_STAGE(PG8_SA(0, 1), cA + hstep, voffA);
        if (wr == 1) PG8_BAR;
        PG8_WAIT_V(2); PG8_BAR;
        PG8_STAGE(PG8_SB(1, 0), cB + kstep, voffB); PG8_STAGE(PG8_SA(1, 0), cA + kstep, voffA); PG8_STAGE(PG8_SB(1, 1), cB + hstep + kstep, voffB);
        PG8_WAIT_V(6); PG8_BAR;
    } else {
        PG8_STAGE(PG8_SB(0, 0), cB, voffB); PG8_STAGE(PG8_SA(0, 0), cA, voffA); PG8_STAGE(PG8_SB(0, 1), cB + hstep, voffB); PG8_STAGE(PG8_SA(0, 1), cA + hstep, voffA);
        if (wr == 1) PG8_BAR;
        PG8_WAIT_V(4); PG8_BAR;
        PG8_STAGE(PG8_SB(1, 0), cB + kstep, voffB); PG8_STAGE(PG8_SA(1, 0), cA + kstep, voffA); PG8_STAGE(PG8_SB(1, 1), cB + hstep + kstep, voffB);
        PG8_WAIT_V(6); PG8_BAR;
    }
    for (;;) {
        const bool has_next = S.next(ui + 1, nxt);
        const char* nA = has_next ? (const char*)g.A + (size_t)nxt.pm * tstep : cA; const char* nB = has_next ? (const char*)g.Bt + (size_t)nxt.pn * tstep : cB;
        for (int t = 0; t < nt; t += 2) {
            const bool last = (t == nt - 2);
            const char* a1 = cA + (size_t)(t + 1) * kstep;
            const char* a2 = last ? nA : cA + (size_t)(t + 2) * kstep; const char* b2 = last ? nB : cB + (size_t)(t + 2) * kstep;
            const char* a3 = a2 + kstep; const char* b3 = b2 + kstep;
            if (last && has_next) S.a_ready(nxt);
            if constexpr (SP2) {
            PG8_LDB(B0, 0, 0); PG8_LDB(B1, 0, 1); PG8_SCHED; PG8_LDA(At, 0, 0); PG8_STAGE(PG8_SA(1, 1), a1 + hstep, voffA);
            PG8_WAIT_V(8); PG8_WAIT_L(0); PG8_BAR; PG8_MMA(0, 0, At, B0); PG8_MMA(0, 1, At, B1); PG8_BAR; PG8_SCHED;
            PG8_LDA(At, 0, 1); PG8_STAGE(PG8_SB(0, 0), b2, voffB); PG8_STAGE(PG8_SB(0, 1), b2 + hstep, voffB); PG8_STAGE(PG8_SA(0, 0), a2, voffA);
            PG8_WAIT_V(8); PG8_WAIT_L(0); PG8_BAR; PG8_MMA(1, 0, At, B0); PG8_MMA(1, 1, At, B1); PG8_BAR; PG8_SCHED;
            PG8_LDB(B0, 1, 0); PG8_LDB(B1, 1, 1); PG8_SCHED; PG8_LDA(At, 1, 0); PG8_STAGE(PG8_SA(0, 1), a2 + hstep, voffA);
            PG8_WAIT_V(8); PG8_WAIT_L(0); PG8_BAR; PG8_MMA(0, 0, At, B0); PG8_MMA(0, 1, At, B1); PG8_BAR; PG8_SCHED;
            PG8_LDA(At, 1, 1); PG8_STAGE(PG8_SB(1, 0), b3, voffB); PG8_STAGE(PG8_SB(1, 1), b3 + hstep, voffB); PG8_STAGE(PG8_SA(1, 0), a3, voffA);
            PG8_WAIT_V(8); PG8_WAIT_L(0); PG8_BAR; PG8_MMA(1, 0, At, B0); PG8_MMA(1, 1, At, B1); PG8_BAR; PG8_SCHED;
            } else {
            PG8_LDB(B0, 0, 0); PG8_SCHED; PG8_LDA(At, 0, 0); PG8_STAGE(PG8_SA(1, 1), a1 + hstep, voffA);
            PG8_WAIT_L(8); PG8_BAR; PG8_WAIT_L(0); PG8_MMA(0, 0, At, B0); PG8_BAR; PG8_SCHED;
            PG8_LDB(B1, 0, 1); PG8_STAGE(PG8_SB(0, 0), b2, voffB);
            PG8_BAR; PG8_WAIT_L(0); PG8_MMA(0, 1, At, B1); PG8_BAR;
            PG8_LDA(At, 0, 1); PG8_STAGE(PG8_SA(0, 0), a2, voffA);
            PG8_BAR; PG8_WAIT_L(0); PG8_MMA(1, 0, At, B0); PG8_BAR; PG8_SCHED;
            PG8_STAGE(PG8_SB(0, 1), b2 + hstep, voffB);
            PG8_WAIT_V(6); PG8_BAR; PG8_MMA(1, 1, At, B1); PG8_BAR;
            PG8_LDB(B0, 1, 0); PG8_SCHED; PG8_LDA(At, 1, 0); PG8_STAGE(PG8_SA(0, 1), a2 + hstep, voffA);
            PG8_WAIT_L(8); PG8_BAR; PG8_WAIT_L(0); PG8_MMA(0, 0, At, B0); PG8_BAR; PG8_SCHED;
            PG8_LDB(B1, 1, 1); PG8_STAGE(PG8_SB(1, 0), b3, voffB);
            PG8_BAR; PG8_WAIT_L(0); PG8_MMA(0, 1, At, B1); PG8_BAR;
            PG8_LDA(At, 1, 1); PG8_STAGE(PG8_SA(1, 0), a3, voffA);
            PG8_BAR; PG8_WAIT_L(0); PG8_MMA(1, 0, At, B0); PG8_BAR; PG8_SCHED;
            PG8_STAGE(PG8_SB(1, 1), b3 + hstep, voffB);
            PG8_WAIT_V(6); PG8_BAR; PG8_MMA(1, 1, At, B1); PG8_BAR;
            }
        }
        if constexpr (ALIGN_EPI) { if (wr == 0) PG8_BAR; }
        if constexpr (!Epi::AFTER_DRAIN) { E(acc, cur, wr, wc, fr, fq); S.done(cur); }
        if (!has_next) break;
#pragma unroll
        for (int a = 0; a < 2; ++a)
#pragma unroll
            for (int b = 0; b < 2; ++b)
#pragma unroll
                for (int m = 0; m < 4; ++m)
#pragma unroll
                    for (int n = 0; n < 2; ++n) acc[a][b][m][n] = (f32x4){0.f, 0.f, 0.f, 0.f};
        cur = nxt; cA = nA; cB = nB; ++ui;
        if constexpr (ALIGN_EPI) { if (wr == 1) PG8_BAR; }
    }
    PG8_WAIT_V(0);
    if constexpr (!ALIGN_EPI) { if (wr == 0) PG8_BAR; }
    PG8_BAR;
    if constexpr (Epi::AFTER_DRAIN) { E.fused(acc, cur, wr, wc, fr, fq, lds, wid, lane); S.done(cur); }
#undef PG8_SA
#undef PG8_SB
#undef PG8_STAGE
#undef PG8_LDA
#undef PG8_LDB
#undef PG8_MMA
#undef PG8_WAIT_V
#undef PG8_WAIT_L
#undef PG8_BAR
#undef PG8_SCHED
}
}
#ifndef PG8_SP2
#define PG8_SP2 true
#endif
#ifndef PG8_ALIGN
#define PG8_ALIGN true
#endif
#ifndef MK_DUP
#define MK_DUP -1
#endif
#ifndef MK_COOP
#define MK_COOP 1
#endif

#define GAS __attribute__((address_space(1)))
#define LAS __attribute__((address_space(3)))
typedef unsigned short bf16;
typedef unsigned v4u __attribute__((ext_vector_type(4)));
typedef unsigned v2u __attribute__((ext_vector_type(2)));
typedef float f32x4 __attribute__((ext_vector_type(4)));
typedef float f32x16 __attribute__((ext_vector_type(16)));
typedef short bf16x8 __attribute__((ext_vector_type(8)));
typedef short s16x4 __attribute__((ext_vector_type(4)));
#define LDS_WAIT() asm volatile("s_waitcnt lgkmcnt(0)" ::: "memory")
__device__ __forceinline__ unsigned pk2(float lo, float hi) { return pg8::cvt_pk_bf16(lo, hi); }
__device__ __forceinline__ float bf_lo(unsigned w) { return __builtin_bit_cast(float, w << 16); }
__device__ __forceinline__ float bf_hi(unsigned w) { return __builtin_bit_cast(float, w & 0xffff0000u); }

constexpr int NWAVES = 8;
constexpr int BATCH = 16, SEQ = 2048, D = 1024, FF = 4096, INW = 2304, M = BATCH * SEQ;
constexpr int NMOD = 6 * D;
constexpr float EPS = 1e-6f;
constexpr int NPH = 10;
constexpr size_t MiB = 1u << 20;
constexpr size_t WS_CTL = 0, WS_WIN = 2 * MiB, WS_WOUT = 7 * MiB, WS_WUP = 9 * MiB, WS_WDN = 17 * MiB, WS_MOD = 25 * MiB, WS_ROPE = 26 * MiB, WS_LSE = 28 * MiB;
constexpr size_t WS_XN = 36 * MiB, WS_PROJ = 100 * MiB, WS_MIXED = 244 * MiB, WS_PART = 308 * MiB, WS_H = 100 * MiB, WS_Y = 420 * MiB  , WS_X1 = 356 * MiB  , WS_Y2 = 36 * MiB, WS_END = 484 * MiB;
constexpr int LDS_BYTES = 155648;

struct Frame {
    LAS unsigned char* lds;
    int tid, lane, wave, G;
    const float *x, *c, *w_ada, *b_ada, *g_attn_pre, *g_attn_post, *w_in, *sink_a, *g_mix_a, *g_mix_b, *w_out, *g_mlp_pre, *g_mlp_post, *w_up, *w_down;
    const int* positions;
    float* out;
    bf16 *Win_t, *Wout_t, *Wup_t, *Wdn_t, *XN, *PROJ, *MIXED, *PART, *HB;
    float *MOD, *ROPE, *LSE, *X1, *RS1; bf16 *Y1, *Y2;
};

__device__ __forceinline__ float wave_sum(float v) {
#pragma unroll
    for (int o = 1; o < 64; o <<= 1) v += __shfl_xor(v, o);
    return v;
}
__device__ __forceinline__ void p0_transpose_item(const float* W, int K, int N, bf16* WT, LAS float* scr, int item, int lane) {
    const int nblk = N / 32, kb = item / nblk, nb = item % nblk, k0 = 64 * kb, n0 = 32 * nb;
    float wv[32];
#pragma unroll
    for (int i = 0; i < 32; ++i) wv[i] = __builtin_nontemporal_load(W + (size_t)(k0 + 2 * i + (lane >> 5)) * N + n0 + (lane & 31));
#pragma unroll
    for (int i = 0; i < 32; ++i) scr[(2 * i + (lane >> 5)) * 33 + (lane & 31)] = wv[i];
    LDS_WAIT(); asm volatile("" ::: "memory");
    const int c = lane & 7;
#pragma unroll
    for (int j = 0; j < 4; ++j) { const int n = (lane >> 3) + 8 * j; const LAS float* s = scr + (8 * c) * 33 + n;
        v4u o; o.x = pk2(s[0 * 33], s[1 * 33]); o.y = pk2(s[2 * 33], s[3 * 33]); o.z = pk2(s[4 * 33], s[5 * 33]); o.w = pk2(s[6 * 33], s[7 * 33]);
        *(GAS v4u*)(WT + (size_t)(n0 + n) * K + k0 + 8 * c) = o; }
    LDS_WAIT(); asm volatile("" ::: "memory");
}
__device__ __forceinline__ double inv_freq_d(int i) {
    switch (i) { case 0: return 1.0; case 1: return 0.19392274474868576; case 2: return 0.03760603093086393; case 3: return 0.007292664737217109;
                 case 4: return 0.001414213562373095; case 5: return 0.0002742481756762073; case 6: return 5.318295896944988e-05; default: return 1.031338537721246e-05; }
}
__device__ __forceinline__ void sincos_d(double ang, float& cs, float& sn) {
    const double t = ang * 0.15915494309189535;
    const double fr = t - __builtin_rint(t);
    const double kq = __builtin_rint(fr * 4.0);
    const double y = (fr - kq * 0.25) * 6.283185307179586;
    const double y2 = y * y;
    double s = -1.0 / 1307674368000.0; s = s * y2 + 1.0 / 6227020800.0; s = s * y2 - 1.0 / 39916800.0; s = s * y2 + 1.0 / 362880.0; s = s * y2 - 1.0 / 5040.0; s = s * y2 + 1.0 / 120.0; s = s * y2 - 1.0 / 6.0; s = s * y2 + 1.0; s = s * y;
    double c = 1.0 / 87178291200.0; c = c * y2 - 1.0 / 479001600.0; c = c * y2 + 1.0 / 3628800.0; c = c * y2 - 1.0 / 40320.0; c = c * y2 + 1.0 / 720.0; c = c * y2 - 1.0 / 24.0; c = c * y2 + 0.5; c = 1.0 - c * y2;
    const int k = ((int)kq) & 3;
    double co = c, so = s;
    if (k == 1) { co = -s; so = c; } else if (k == 2) { co = -c; so = -s; } else if (k == 3) { co = s; so = -c; }
    cs = (float)co; sn = (float)so;
}

__device__ __forceinline__ void p0_prologue(Frame& F) {
    if ((int)blockIdx.x < NMOD / 64) {
        LAS float* condT = (LAS float*)F.lds;
        LAS float* red = (LAS float*)(F.lds + 65536);
        { float cvv[32];
#pragma unroll
          for (int j = 0; j < 32; ++j) cvv[j] = F.c[F.tid + j * (NWAVES * 64)];
#pragma unroll
          for (int j = 0; j < 32; ++j) { const int idx = F.tid + j * (NWAVES * 64), b = idx >> 10, k = idx & 1023; condT[k * 16 + b] = cvv[j] / (1.f + __expf(-cvv[j])); } }
        __syncthreads();
        for (int it = blockIdx.x; it < NMOD / 64; it += F.G) {
            const int n = it * 64 + F.lane, k0 = F.wave * 128;
            float acc[16];
#pragma unroll
            for (int b = 0; b < 16; ++b) acc[b] = 0.f;
#pragma unroll 1
            for (int kb = k0; kb < k0 + 128; kb += 16) {
                const float* wp = F.w_ada + (size_t)kb * NMOD + n;
                f32x4 w0, w1, w2, w3;
                w0[0] = wp[0]; w0[1] = wp[NMOD]; w0[2] = wp[2 * NMOD]; w0[3] = wp[3 * NMOD]; w1[0] = wp[4 * NMOD]; w1[1] = wp[5 * NMOD]; w1[2] = wp[6 * NMOD]; w1[3] = wp[7 * NMOD];
                w2[0] = wp[8 * NMOD]; w2[1] = wp[9 * NMOD]; w2[2] = wp[10 * NMOD]; w2[3] = wp[11 * NMOD]; w3[0] = wp[12 * NMOD]; w3[1] = wp[13 * NMOD]; w3[2] = wp[14 * NMOD]; w3[3] = wp[15 * NMOD];
                asm volatile("" : "+v"(w0), "+v"(w1), "+v"(w2), "+v"(w3));
#pragma unroll
                for (int j = 0; j < 16; ++j) { const float w = j < 4 ? w0[j & 3] : (j < 8 ? w1[j & 3] : (j < 12 ? w2[j & 3] : w3[j & 3]));
                    const LAS f32x4* cp = (const LAS f32x4*)(condT + (kb + j) * 16);
#pragma unroll
                    for (int q = 0; q < 4; ++q) { const f32x4 cv = cp[q]; acc[4 * q + 0] += cv[0] * w; acc[4 * q + 1] += cv[1] * w; acc[4 * q + 2] += cv[2] * w; acc[4 * q + 3] += cv[3] * w; }
                    asm volatile("" : "+v"(acc[0]), "+v"(acc[15])); }
            }
#pragma unroll
            for (int b = 0; b < 16; ++b) red[(F.wave * 16 + b) * 64 + F.lane] = acc[b];
            __syncthreads();
            for (int o = F.tid; o < 1024; o += NWAVES * 64) { const int b = o >> 6, col = o & 63; float s = 0.f;
#pragma unroll
                for (int w = 0; w < 8; ++w) s += red[(w * 16 + b) * 64 + col];
                F.MOD[b * NMOD + it * 64 + col] = s + F.b_ada[it * 64 + col]; }
            __syncthreads();
        }
    }
    __syncthreads();
    LAS float* scr = (LAS float*)(F.lds + F.wave * 16384);
    const int gw = blockIdx.x * NWAVES + F.wave, NGW = F.G * NWAVES;
    constexpr int I_IN = (D / 64) * (INW / 32), I_OUT = (D / 64) * (D / 32), I_UP = (D / 64) * (FF / 32), I_DN = (FF / 64) * (D / 32);
    constexpr int NITEMS = I_IN + I_OUT + I_UP + I_DN;
    const int TB0 = (F.G == 256) ? NMOD / 64 : 0, tgw = ((int)blockIdx.x - TB0) * NWAVES + F.wave, TNGW = (F.G - TB0) * NWAVES;
    for (int it = ((int)blockIdx.x >= TB0) ? tgw : NITEMS; it < NITEMS; it += TNGW) {
        int r = it;
        if (r < I_IN) { p0_transpose_item(F.w_in, D, INW, F.Win_t, scr, r, F.lane); continue; } r -= I_IN;
        if (r < I_OUT) { p0_transpose_item(F.w_out, D, D, F.Wout_t, scr, r, F.lane); continue; } r -= I_OUT;
        if (r < I_UP) { p0_transpose_item(F.w_up, D, FF, F.Wup_t, scr, r, F.lane); continue; } r -= I_UP;
        p0_transpose_item(F.w_down, FF, D, F.Wdn_t, scr, r, F.lane);
    }
    for (int idx = blockIdx.x * (NWAVES * 64) + F.tid; idx < M * 8; idx += F.G * NWAVES * 64) {
        const int row = idx >> 3, i = idx & 7;
        const float angf = (float)F.positions[row] * (float)inv_freq_d(i);
        float cs, sn; sincos_d((double)angf, cs, sn);
        F.ROPE[row * 16 + i] = cs; F.ROPE[row * 16 + 8 + i] = sn;
    }
}

__device__ __forceinline__ void p1_prenorm(Frame& F) {
    const int gw = blockIdx.x * NWAVES + F.wave, NGW = F.G * NWAVES;
    for (int m0 = 4 * gw; m0 < M; m0 += 4 * NGW) {
        const int b = m0 / SEQ; const float* mod = F.MOD + b * NMOD;
        f32x4 v[4][4]; float s[4] = {0.f, 0.f, 0.f, 0.f};
#pragma unroll
        for (int t = 0; t < 4; ++t) { const f32x4* xr = (const f32x4*)(F.x + (size_t)(m0 + t) * D) + F.lane;
#pragma unroll
            for (int j = 0; j < 4; ++j) v[t][j] = __builtin_nontemporal_load(xr + 64 * j); }
#pragma unroll
        for (int t = 0; t < 4; ++t)
#pragma unroll
            for (int j = 0; j < 4; ++j) s[t] += (v[t][j].x * v[t][j].x + v[t][j].y * v[t][j].y) + (v[t][j].z * v[t][j].z + v[t][j].w * v[t][j].w);
        float rs[4];
#pragma unroll
        for (int t = 0; t < 4; ++t) rs[t] = 1.0f / sqrtf(wave_sum(s[t]) * (1.f / D) + EPS);
#pragma unroll
        for (int j = 0; j < 4; ++j) { const int col = 4 * F.lane + 256 * j;
            const f32x4 g = *(const f32x4*)(F.g_attn_pre + col), sh = *(const f32x4*)(mod + col), sc = *(const f32x4*)(mod + D + col);
#pragma unroll
            for (int t = 0; t < 4; ++t) { unsigned long long* o8 = (unsigned long long*)(F.XN + (size_t)(m0 + t) * D) + F.lane;
                const f32x4 h = (v[t][j] * rs[t] * g) * (sc + 1.f) + sh;
                o8[64 * j] = (unsigned long long)pk2(h.x, h.y) | ((unsigned long long)pk2(h.z, h.w) << 32); } }
    }
}
__device__ __forceinline__ void p4_combine(Frame& F) {
    const int gw = blockIdx.x * NWAVES + F.wave, NGW = F.G * NWAVES;
    constexpr size_t PSTR = (size_t)M * 512;
    const int hd = F.lane >> 3;
    const f32x4 ga0 = *(const f32x4*)(F.g_mix_a + 8 * F.lane), ga1 = *(const f32x4*)(F.g_mix_a + 8 * F.lane + 4), gb0 = *(const f32x4*)(F.g_mix_b + 8 * F.lane), gb1 = *(const f32x4*)(F.g_mix_b + 8 * F.lane + 4);
    for (int m0 = 4 * gw; m0 < M; m0 += 4 * NGW) {
        v4u pa[4], p1[4], p2[4], p3[4]; float l1[4], l2[4], l3[4];
#pragma unroll
        for (int t = 0; t < 4; ++t) { const int m = m0 + t; const size_t off = (size_t)m * 512 + 8 * F.lane;
            pa[t] = *(const v4u*)(F.PART + off); p1[t] = *(const v4u*)(F.PART + PSTR + off); p2[t] = *(const v4u*)(F.PART + 2 * PSTR + off); p3[t] = *(const v4u*)(F.PART + 3 * PSTR + off);
            l1[t] = F.LSE[(size_t)hd * M + m]; l2[t] = F.LSE[(size_t)(8 + hd) * M + m]; l3[t] = F.LSE[(size_t)(16 + hd) * M + m]; }
#pragma unroll
        for (int t = 0; t < 4; ++t) { const int m = m0 + t;
            const float mx = fmaxf(l1[t], fmaxf(l2[t], l3[t]));
            float w1 = __expf(l1[t] - mx), w2 = __expf(l2[t] - mx), w3 = __expf(l3[t] - mx); const float inv = 1.f / (w1 + w2 + w3); w1 *= inv; w2 *= inv; w3 *= inv;
            float oa[8], ob[8]; float sa = 0.f, sb = 0.f;
#pragma unroll
            for (int q = 0; q < 4; ++q) {
                oa[2 * q] = bf_lo(pa[t][q]); oa[2 * q + 1] = bf_hi(pa[t][q]);
                ob[2 * q] = w1 * bf_lo(p1[t][q]) + w2 * bf_lo(p2[t][q]) + w3 * bf_lo(p3[t][q]); ob[2 * q + 1] = w1 * bf_hi(p1[t][q]) + w2 * bf_hi(p2[t][q]) + w3 * bf_hi(p3[t][q]);
                sa += oa[2 * q] * oa[2 * q] + oa[2 * q + 1] * oa[2 * q + 1]; sb += ob[2 * q] * ob[2 * q] + ob[2 * q + 1] * ob[2 * q + 1]; }
            const float ra = 1.0f / sqrtf(wave_sum(sa) * (1.f / 512.f) + EPS), rb = 1.0f / sqrtf(wave_sum(sb) * (1.f / 512.f) + EPS);
            v4u wa, wb;
            wa.x = pk2(oa[0] * ra * ga0[0], oa[1] * ra * ga0[1]); wa.y = pk2(oa[2] * ra * ga0[2], oa[3] * ra * ga0[3]); wa.z = pk2(oa[4] * ra * ga1[0], oa[5] * ra * ga1[1]); wa.w = pk2(oa[6] * ra * ga1[2], oa[7] * ra * ga1[3]);
            wb.x = pk2(ob[0] * rb * gb0[0], ob[1] * rb * gb0[1]); wb.y = pk2(ob[2] * rb * gb0[2], ob[3] * rb * gb0[3]); wb.z = pk2(ob[4] * rb * gb1[0], ob[5] * rb * gb1[1]); wb.w = pk2(ob[6] * rb * gb1[2], ob[7] * rb * gb1[3]);
            *(v4u*)(F.MIXED + (size_t)m * D + 8 * F.lane) = wa; *(v4u*)(F.MIXED + (size_t)m * D + 512 + 8 * F.lane) = wb; }
    }
}
__device__ __forceinline__ void p6_mid(Frame& F) {
    const int gw = blockIdx.x * NWAVES + F.wave, NGW = F.G * NWAVES;
    for (int m0 = 2 * gw; m0 < M; m0 += 2 * NGW) {
        const int b = m0 / SEQ; const float* mod = F.MOD + b * NMOD;
        f32x4 v[2][4], xv[2][4]; float s[2] = {0.f, 0.f};
#pragma unroll
        for (int t = 0; t < 2; ++t) { const v2u* yr = (const v2u*)(F.Y1 + (size_t)(m0 + t) * D) + F.lane; const f32x4* xr = (const f32x4*)(F.x + (size_t)(m0 + t) * D) + F.lane;
#pragma unroll
            for (int j = 0; j < 4; ++j) { const v2u w = yr[64 * j]; v[t][j] = (f32x4){bf_lo(w.x), bf_hi(w.x), bf_lo(w.y), bf_hi(w.y)}; xv[t][j] = __builtin_nontemporal_load(xr + 64 * j); } }
#pragma unroll
        for (int t = 0; t < 2; ++t)
#pragma unroll
            for (int j = 0; j < 4; ++j) s[t] += (v[t][j].x * v[t][j].x + v[t][j].y * v[t][j].y) + (v[t][j].z * v[t][j].z + v[t][j].w * v[t][j].w);
        float rs[2], s2[2] = {0.f, 0.f};
#pragma unroll
        for (int t = 0; t < 2; ++t) { rs[t] = 1.0f / sqrtf(wave_sum(s[t]) * (1.f / D) + EPS); if (F.lane == 0) F.RS1[m0 + t] = rs[t]; }
#pragma unroll
        for (int j = 0; j < 4; ++j) { const int col = 4 * F.lane + 256 * j;
            const f32x4 gg = *(const f32x4*)(F.g_attn_post + col) * *(const f32x4*)(mod + 2 * D + col);
#pragma unroll
            for (int t = 0; t < 2; ++t) {
                xv[t][j] = xv[t][j] + gg * (v[t][j] * rs[t]);
                s2[t] += (xv[t][j].x * xv[t][j].x + xv[t][j].y * xv[t][j].y) + (xv[t][j].z * xv[t][j].z + xv[t][j].w * xv[t][j].w); } }
        float rs2[2];
#pragma unroll
        for (int t = 0; t < 2; ++t) rs2[t] = 1.0f / sqrtf(wave_sum(s2[t]) * (1.f / D) + EPS);
#pragma unroll
        for (int j = 0; j < 4; ++j) { const int col = 4 * F.lane + 256 * j;
            const f32x4 g = *(const f32x4*)(F.g_mlp_pre + col), sh = *(const f32x4*)(mod + 3 * D + col), sc = *(const f32x4*)(mod + 4 * D + col);
#pragma unroll
            for (int t = 0; t < 2; ++t) { unsigned long long* o8 = (unsigned long long*)(F.XN + (size_t)(m0 + t) * D) + F.lane;
                const f32x4 h = (xv[t][j] * rs2[t] * g) * (sc + 1.f) + sh;
                o8[64 * j] = (unsigned long long)pk2(h.x, h.y) | ((unsigned long long)pk2(h.z, h.w) << 32); } }
    }
}
__device__ __forceinline__ void p9_final(Frame& F) {
    const int gw = blockIdx.x * NWAVES + F.wave, NGW = F.G * NWAVES;
    for (int m0 = 2 * gw; m0 < M; m0 += 2 * NGW) {
        const int b = m0 / SEQ; const float* mod = F.MOD + b * NMOD;
        f32x4 v1[2][4], v2[2][4], xv[2][4]; float s[2] = {0.f, 0.f}, rs1[2];
#pragma unroll
        for (int t = 0; t < 2; ++t) { const v2u* y1r = (const v2u*)(F.Y1 + (size_t)(m0 + t) * D) + F.lane; const v2u* y2r = (const v2u*)(F.Y2 + (size_t)(m0 + t) * D) + F.lane; const f32x4* xr = (const f32x4*)(F.x + (size_t)(m0 + t) * D) + F.lane;
            rs1[t] = F.RS1[m0 + t];
#pragma unroll
            for (int j = 0; j < 4; ++j) { const v2u w1 = y1r[64 * j], w2 = y2r[64 * j]; v1[t][j] = (f32x4){bf_lo(w1.x), bf_hi(w1.x), bf_lo(w1.y), bf_hi(w1.y)}; v2[t][j] = (f32x4){bf_lo(w2.x), bf_hi(w2.x), bf_lo(w2.y), bf_hi(w2.y)};
                xv[t][j] = __builtin_nontemporal_load(xr + 64 * j); } }
#pragma unroll
        for (int t = 0; t < 2; ++t)
#pragma unroll
            for (int j = 0; j < 4; ++j) s[t] += (v2[t][j].x * v2[t][j].x + v2[t][j].y * v2[t][j].y) + (v2[t][j].z * v2[t][j].z + v2[t][j].w * v2[t][j].w);
        float rs[2];
#pragma unroll
        for (int t = 0; t < 2; ++t) rs[t] = 1.0f / sqrtf(wave_sum(s[t]) * (1.f / D) + EPS);
#pragma unroll
        for (int j = 0; j < 4; ++j) { const int col = 4 * F.lane + 256 * j;
            const f32x4 gga = *(const f32x4*)(F.g_attn_post + col) * *(const f32x4*)(mod + 2 * D + col), ggm = *(const f32x4*)(F.g_mlp_post + col) * *(const f32x4*)(mod + 5 * D + col);
#pragma unroll
            for (int t = 0; t < 2; ++t) { f32x4* orow = (f32x4*)(F.out + (size_t)(m0 + t) * D) + F.lane;
                const f32x4 x1 = xv[t][j] + gga * (v1[t][j] * rs1[t]);
                __builtin_nontemporal_store(x1 + ggm * (v2[t][j] * rs[t]), orow + 64 * j); } }
    }
}

constexpr int VROW = 144;
constexpr int ATT_WAVE_LDS = 18432;
constexpr float SC2 = 0.125f * 1.4426950408889634f;
typedef short v4i16_t __attribute__((ext_vector_type(4)));
__device__ __forceinline__ s16x4 vtr(const LAS unsigned char* p) { return __builtin_bit_cast(s16x4, __builtin_amdgcn_ds_read_tr16_b64_v4i16((LAS v4i16_t*)p)); }

struct AttnP { int br, d, i0, kt0, qcol, kcol, vcol, maxd, h; size_t rowbase; };
__device__ __forceinline__ AttnP attn_decode(int w, int k, int wv) {
    AttnP p; const int br = k >> 1, j = 2 * w + (k & 1), h = j & 7, tg = (j >> 3) * 8 + wv, b = tg >> 5, tt = tg & 31; p.h = h;
    const int dsh = br < 2 ? 0 : (br == 2 ? 2 : 4);
    const int r = tt >> (5 - dsh), it = tt & ((32 >> dsh) - 1);
    p.br = br; p.d = 1 << dsh; p.i0 = it * 64; p.kt0 = it < 2 ? 4 - 2 * it : 0;
    p.qcol = br == 0 ? h * 64 : 768 + h * 64; p.kcol = br == 0 ? 512 + (h >> 2) * 64 : 1280 + h * 64; p.vcol = br == 0 ? 640 + (h >> 2) * 64 : 1792 + h * 64;
    p.maxd = br == 0 ? 127 : 128; p.rowbase = (size_t)b * SEQ + r;
    return p;
}
__device__ __forceinline__ void attn_loads(const bf16* P, unsigned sk, unsigned sv, unsigned lv, unsigned vstep, v4u (&kr)[4], v4u (&vr)[4]) {
    const char* Pb = (const char*)P;
#pragma unroll
    for (int i = 0; i < 4; ++i) kr[i] = *(const v4u*)(Pb + (size_t)(sk + lv + vstep * i));
#pragma unroll
    for (int i = 0; i < 4; ++i) vr[i] = *(const v4u*)(Pb + (size_t)(sv + lv + vstep * i));
}
__device__ __forceinline__ unsigned attn_tile_base(const AttnP& p, int kt, int col) { return (unsigned)(((unsigned)(col >> 6) * (unsigned)M + (unsigned)p.rowbase + (unsigned)p.d * (unsigned)(p.i0 - 128 + 32 * kt)) * 64u) * 2u; }
constexpr int QROW = 144;
__device__ __forceinline__ void attn_qload(const bf16* P, const AttnP& p, int lane, v4u (&qt)[8]) {
    const char* Pb = (const char*)P;
    const unsigned base = (unsigned)(((unsigned)(p.qcol >> 6) * (unsigned)M + (unsigned)p.rowbase + (unsigned)p.d * (unsigned)(p.i0 + (lane >> 3))) * 64u + (unsigned)(8 * (lane & 7))) * 2u, step = (unsigned)(8 * p.d * 64 * 2);
#pragma unroll
    for (int i = 0; i < 8; ++i) qt[i] = *(const v4u*)(Pb + (size_t)(base + step * i));
}
__device__ __forceinline__ void attn_qstore(LAS unsigned char* ql, int lane, const v4u (&qt)[8]) {
#pragma unroll
    for (int i = 0; i < 8; ++i) *(LAS v4u*)(ql + ((lane >> 3) + 8 * i) * QROW + (lane & 7) * 16) = qt[i];
}

struct AttnSt { float mrun[2], lrun[2]; f32x16 O0[2], O1[2]; };
template <int MASK> __device__ __forceinline__ void attn_half(AttnSt& st, const int a, f32x16 S, const bf16x8 (&va0)[2], const bf16x8 (&va1)[2], int qh  , int farlim  ) {
    if (MASK == 1) {
#pragma unroll
        for (int i = 0; i < 16; ++i) S[i] = (qh <= farlim + (8 * (i >> 2) + (i & 3))) ? S[i] : -1e30f;
    } else if (MASK == 2) {
#pragma unroll
        for (int i = 0; i < 16; ++i) S[i] = (qh >= (8 * (i >> 2) + (i & 3))) ? S[i] : -1e30f;
    }
    float mx = S[0];
#pragma unroll
    for (int i = 1; i < 16; ++i) mx = fmaxf(mx, S[i]);
    mx = fmaxf(mx, __shfl_xor(mx, 32));
    const float mnew = fmaxf(st.mrun[a], mx), alpha = __builtin_amdgcn_exp2f((st.mrun[a] - mnew) * SC2), nb = -mnew * SC2;
    float rsum = 0.f;
#pragma unroll
    for (int i = 0; i < 16; ++i) { S[i] = __builtin_amdgcn_exp2f(__builtin_fmaf(S[i], SC2, nb)); rsum += S[i]; }
    rsum += __shfl_xor(rsum, 32);
    st.lrun[a] = st.lrun[a] * alpha + rsum; st.mrun[a] = mnew;
#pragma unroll
    for (int i = 0; i < 16; ++i) { st.O0[a][i] *= alpha; st.O1[a][i] *= alpha; }
#pragma unroll
    for (int kk = 0; kk < 2; ++kk) {
        v4u pw; pw.x = pk2(S[8 * kk + 0], S[8 * kk + 1]); pw.y = pk2(S[8 * kk + 2], S[8 * kk + 3]); pw.z = pk2(S[8 * kk + 4], S[8 * kk + 5]); pw.w = pk2(S[8 * kk + 6], S[8 * kk + 7]);
        const bf16x8 pb = __builtin_bit_cast(bf16x8, pw);
        st.O0[a] = __builtin_amdgcn_mfma_f32_32x32x16_bf16(va0[kk], pb, st.O0[a], 0, 0, 0);
        st.O1[a] = __builtin_amdgcn_mfma_f32_32x32x16_bf16(va1[kk], pb, st.O1[a], 0, 0, 0); }
}
template <int KT> __device__ __forceinline__ void attn_step(AttnSt& st, const bf16* P, const AttnP& p, const AttnP& pn, unsigned lv, unsigned lvn,
                                                            LAS unsigned char* vl, const LAS unsigned char* qrd, const LAS unsigned char* trb, int lane, v4u (&kn)[4], v4u (&vn)[4]) {
    asm volatile("" ::: "memory");
#pragma unroll
    for (int i = 0; i < 4; ++i) { *(LAS v4u*)(vl + ((lane >> 3) + 8 * i) * VROW + (lane & 7) * 16) = vn[i]; *(LAS v4u*)(vl + 32 * VROW + ((lane >> 3) + 8 * i) * VROW + (lane & 7) * 16) = kn[i]; }
    if (KT < 5) attn_loads(P, attn_tile_base(p, KT + 1, p.kcol), attn_tile_base(p, KT + 1, p.vcol), lv, (unsigned)(8 * p.d * 64 * 2), kn, vn);
    else        attn_loads(P, attn_tile_base(pn, pn.kt0, pn.kcol), attn_tile_base(pn, pn.kt0, pn.vcol), lvn, (unsigned)(8 * pn.d * 64 * 2), kn, vn);
    bf16x8 kf[4];
#pragma unroll
    for (int kd = 0; kd < 4; ++kd) kf[kd] = *(const LAS bf16x8*)(qrd - 32 * VROW + kd * 32);
    constexpr bool act0 = KT <= 4, act1 = KT >= 1;
    f32x16 S0, S1;
#pragma unroll
    for (int i = 0; i < 16; ++i) { S0[i] = 0.f; S1[i] = 0.f; }
#pragma unroll
    for (int kd = 0; kd < 4; ++kd) {
        if (act0) S0 = __builtin_amdgcn_mfma_f32_32x32x16_bf16(kf[kd], *(const LAS bf16x8*)(qrd + kd * 32), S0, 0, 0, 0);
        if (act1) S1 = __builtin_amdgcn_mfma_f32_32x32x16_bf16(kf[kd], *(const LAS bf16x8*)(qrd + 32 * QROW + kd * 32), S1, 0, 0, 0);
    }
    bf16x8 va0[2], va1[2];
#pragma unroll
    for (int kk = 0; kk < 2; ++kk) {
        const s16x4 lo0 = vtr(trb + kk * 16 * VROW), up0 = vtr(trb + kk * 16 * VROW + 8 * VROW), lo1 = vtr(trb + kk * 16 * VROW + 64), up1 = vtr(trb + kk * 16 * VROW + 8 * VROW + 64);
        va0[kk] = (bf16x8){lo0[0], lo0[1], lo0[2], lo0[3], up0[0], up0[1], up0[2], up0[3]}; va1[kk] = (bf16x8){lo1[0], lo1[1], lo1[2], lo1[3], up1[0], up1[1], up1[2], up1[3]}; }
    const int qh = (lane & 31) - 4 * (lane >> 5), farlim = p.maxd - 128;
    if (act0) attn_half<KT == 0 ? 1 : (KT == 4 ? 2 : 0)>(st, 0, S0, va0, va1, qh, farlim);
    if (act1) attn_half<KT == 1 ? 1 : (KT == 5 ? 2 : 0)>(st, 1, S1, va0, va1, qh, farlim);
    asm volatile("" ::: "memory");
}

__device__ __forceinline__ void attn_phase(Frame& F) {
    const int lane = F.lane, wv = F.wave, q = lane & 31, hi = lane >> 5;
    LAS unsigned char* vl = F.lds + wv * ATT_WAVE_LDS;
    LAS unsigned char* ql = vl + 64 * VROW;
    const LAS unsigned char* qrd = ql + q * QROW + hi * 16;
    const LAS unsigned char* trb = vl + (4 * hi + ((lane & 15) >> 2)) * VROW + (16 * ((lane >> 4) & 1) + 4 * (lane & 3)) * 2;
    const bf16* P = F.PROJ;
    const int bx = blockIdx.x, w = (bx & 7) * 32 + (bx >> 3);
    if (F.G != 256) return;
    AttnP p = attn_decode(w, 0, wv), pn = attn_decode(w, 1, wv);
    v4u kn[4], vn[4];
    { v4u qt[8]; attn_qload(P, p, lane, qt); attn_qstore(ql, lane, qt); }
    unsigned lv = (unsigned)(((lane >> 3) * p.d) * 64 + 8 * (lane & 7)) * 2u, lvn = (unsigned)(((lane >> 3) * pn.d) * 64 + 8 * (lane & 7)) * 2u;
    attn_loads(P, attn_tile_base(p, p.kt0, p.kcol), attn_tile_base(p, p.kt0, p.vcol), lv, (unsigned)(8 * p.d * 64 * 2), kn, vn);
#pragma unroll 1
    for (int k = 0; k < 8; ++k) {
        AttnSt st;
#pragma unroll
        for (int a = 0; a < 2; ++a) { st.mrun[a] = p.br == 0 ? F.sink_a[p.h] * 8.0f : -5e29f; st.lrun[a] = p.br == 0 ? 1.f : 0.f;
#pragma unroll
            for (int i = 0; i < 16; ++i) { st.O0[a][i] = 0.f; st.O1[a][i] = 0.f; } }
        if (p.kt0 <= 0) attn_step<0>(st, P, p, pn, lv, lvn, vl, qrd, trb, lane, kn, vn);
        if (p.kt0 <= 1) attn_step<1>(st, P, p, pn, lv, lvn, vl, qrd, trb, lane, kn, vn);
        if (p.kt0 <= 2) attn_step<2>(st, P, p, pn, lv, lvn, vl, qrd, trb, lane, kn, vn);
        if (p.kt0 <= 3) attn_step<3>(st, P, p, pn, lv, lvn, vl, qrd, trb, lane, kn, vn);
        attn_step<4>(st, P, p, pn, lv, lvn, vl, qrd, trb, lane, kn, vn);
        v4u qt[8];
        if (k < 7) attn_qload(P, pn, lane, qt);
        attn_step<5>(st, P, p, pn, lv, lvn, vl, qrd, trb, lane, kn, vn);
        if (k < 7) { asm volatile("" ::: "memory"); attn_qstore(ql, lane, qt); }
#pragma unroll
        for (int a = 0; a < 2; ++a) {
            const float invl = 1.f / st.lrun[a];
            asm volatile("" ::: "memory");
#pragma unroll
            for (int g = 0; g < 4; ++g) {
                v2u w0, w1; w0.x = pk2(st.O0[a][4 * g] * invl, st.O0[a][4 * g + 1] * invl); w0.y = pk2(st.O0[a][4 * g + 2] * invl, st.O0[a][4 * g + 3] * invl);
                w1.x = pk2(st.O1[a][4 * g] * invl, st.O1[a][4 * g + 1] * invl); w1.y = pk2(st.O1[a][4 * g + 2] * invl, st.O1[a][4 * g + 3] * invl);
                *(LAS v2u*)(vl + q * VROW + (8 * g + 4 * hi) * 2) = w0; *(LAS v2u*)(vl + q * VROW + (32 + 8 * g + 4 * hi) * 2) = w1; }
            asm volatile("s_waitcnt lgkmcnt(0)" ::: "memory");
            v4u orw[4];
#pragma unroll
            for (int i = 0; i < 4; ++i) orw[i] = *(const LAS v4u*)(vl + ((lane >> 3) + 8 * i) * VROW + (lane & 7) * 16);
            asm volatile("s_waitcnt lgkmcnt(0)" : "+v"(orw[0]), "+v"(orw[1]), "+v"(orw[2]), "+v"(orw[3]) :: "memory");
            bf16* ob = F.PART + (size_t)p.br * M * 512 + p.h * 64 + 8 * (lane & 7);
#pragma unroll
            for (int i = 0; i < 4; ++i) *(v4u*)(ob + (p.rowbase + (size_t)p.d * (p.i0 + 32 * a + (lane >> 3) + 8 * i)) * 512) = orw[i];
#pragma unroll
            for (int i = 0; i < 4; ++i) asm volatile("v_mov_b32 %0, %0\n\tv_mov_b32 %1, %1\n\tv_mov_b32 %2, %2\n\tv_mov_b32 %3, %3" : "+v"(orw[i].x), "+v"(orw[i].y), "+v"(orw[i].z), "+v"(orw[i].w) :: "memory");
            if (p.br > 0 && hi == 0) F.LSE[((size_t)(p.br - 1) * 8 + p.h) * M + p.rowbase + (size_t)p.d * (p.i0 + 32 * a + q)] = st.mrun[a] * 0.125f + __logf(st.lrun[a]);
        }
        if (k == 7) break;
        p = pn; pn = attn_decode(w, k + 2 < 8 ? k + 2 : 7, wv);
        lv = lvn; lvn = (unsigned)(((lane >> 3) * pn.d) * 64 + 8 * (lane & 7)) * 2u;
    }
}

#define XB_TMO      128
#define XB_XCNT(j)  (256  + 64 * (j))
#define XB_XSUB(j)  (1280 + 64 * (j))
#define XB_XGEN(j)  (2304 + 64 * (j))
#define XB_TOP      3328
#define XB_TOPGEN   3392
#define XCD_BAR_WORDS 3456
#define XB_SPIN_CAP (1u << 18)

__device__ __forceinline__ unsigned xb_ld(unsigned* p)              { return __hip_atomic_load(p, __ATOMIC_RELAXED, __HIP_MEMORY_SCOPE_AGENT); }
__device__ __forceinline__ unsigned xb_add(unsigned* p, unsigned v) { return __hip_atomic_fetch_add(p, v, __ATOMIC_RELAXED, __HIP_MEMORY_SCOPE_AGENT); }
__device__ __forceinline__ unsigned xb_xcc_id() { return (unsigned)__builtin_amdgcn_s_getreg((3 << 11) | 20) & 0xFu; }
#define XB_SPIN(cond, bar) do { unsigned _sp = 0; while (cond) { __builtin_amdgcn_s_sleep(1); \
    if ((++_sp & 255u) == 0u) { if (xb_ld(&(bar)[XB_TMO])) break; if (_sp > XB_SPIN_CAP) { atomicAdd(&(bar)[XB_TMO], 1u); break; } } } } while (0)

struct XcdBarrier {
    unsigned* bar; unsigned x;
    volatile LAS unsigned* st;
};

__device__ __forceinline__ XcdBarrier xcd_barrier_post(unsigned* bar, volatile LAS unsigned* st) {
    XcdBarrier b; b.bar = bar; b.x = xb_xcc_id(); b.st = st;
    if (threadIdx.x == 0) (void)xb_add(&bar[XB_XCNT(b.x)], 1u);
    return b;
}
__device__ __forceinline__ void xcd_barrier_complete(unsigned* bar, unsigned x, unsigned& nloc, unsigned& nx) {
    const unsigned G = gridDim.x * gridDim.y * gridDim.z;
    unsigned sum, cnt, mine, sp = 0u;
    for (;;) {
        sum = 0u; cnt = 0u; mine = 0u;
#pragma unroll
        for (unsigned j = 0; j < 16; ++j) { const unsigned c = xb_ld(&bar[XB_XCNT(j)]); sum += c; cnt += (c > 0u) ? 1u : 0u; mine = (j == x) ? c : mine; }
        if (sum == G) break;
        __builtin_amdgcn_s_sleep(1);
        if ((++sp & 255u) == 0u) { if (xb_ld(&bar[XB_TMO])) break; if (sp > XB_SPIN_CAP) { atomicAdd(&bar[XB_TMO], 1u); break; } }
    }
    nloc = mine > 0u ? mine : 1u; nx = cnt > 0u ? cnt : 1u;
}

__device__ __forceinline__ void xcd_barrier(const XcdBarrier& b) {
    asm volatile("s_waitcnt vmcnt(0)" ::: "memory");
    __syncthreads();
    if (threadIdx.x == 0) {
        unsigned* bar = b.bar;
        __builtin_amdgcn_s_waitcnt(0);
        unsigned nloc = b.st[0], nx = b.st[1];
        if (nloc == 0u) { xcd_barrier_complete(bar, b.x, nloc, nx); b.st[0] = nloc; b.st[1] = nx; }
        const unsigned old = xb_add(&bar[XB_XSUB(b.x)], 1u);
        const unsigned gen = old / nloc;
        if (old + 1u == (gen + 1u) * nloc) {
            __builtin_amdgcn_fence(__ATOMIC_RELEASE, "agent");
            asm volatile("s_waitcnt vmcnt(0)" ::: "memory");
            const unsigned og = xb_add(&bar[XB_TOP], 1u);
            const unsigned tg = og / nx;
            if (og + 1u == (tg + 1u) * nx) xb_add(&bar[XB_TOPGEN], 1u);
            else XB_SPIN(xb_ld(&bar[XB_TOPGEN]) == tg, bar);
            __builtin_amdgcn_fence(__ATOMIC_ACQUIRE, "agent");
            xb_add(&bar[XB_XGEN(b.x)], 1u);
            asm volatile("s_waitcnt vmcnt(0)" ::: "memory");
        } else {
            XB_SPIN(xb_ld(&bar[XB_XGEN(b.x)]) == gen, bar);
            __builtin_amdgcn_fence(__ATOMIC_ACQUIRE, "agent");
            asm volatile("s_waitcnt vmcnt(0)" ::: "memory");
        }
    }
    __syncthreads();
}

struct Args { const void* in[16]; float* out; unsigned char* ws; int ph_lo, ph_hi; };
__global__ void __launch_bounds__(NWAVES * 64, 2) fwd_kernel(Args args) {
    extern __shared__ __attribute__((aligned(16))) unsigned char lds[];
    cooperative_groups::grid_group grid = cooperative_groups::this_grid();
    Frame F;
    F.lds = (LAS unsigned char*)lds;
    F.tid = threadIdx.x; F.lane = F.tid & 63; F.wave = __builtin_amdgcn_readfirstlane(F.tid >> 6); F.G = gridDim.x;
    unsigned char* ws = args.ws;
    F.x = (const float*)args.in[0]; F.c = (const float*)args.in[1]; F.positions = (const int*)args.in[2]; F.w_ada = (const float*)args.in[3]; F.b_ada = (const float*)args.in[4];
    F.g_attn_pre = (const float*)args.in[5]; F.g_attn_post = (const float*)args.in[6]; F.w_in = (const float*)args.in[7]; F.sink_a = (const float*)args.in[8];
    F.g_mix_a = (const float*)args.in[9]; F.g_mix_b = (const float*)args.in[10]; F.w_out = (const float*)args.in[11]; F.g_mlp_pre = (const float*)args.in[12]; F.g_mlp_post = (const float*)args.in[13];
    F.w_up = (const float*)args.in[14]; F.w_down = (const float*)args.in[15]; F.out = args.out;
    F.Win_t = (bf16*)(ws + WS_WIN); F.Wout_t = (bf16*)(ws + WS_WOUT); F.Wup_t = (bf16*)(ws + WS_WUP); F.Wdn_t = (bf16*)(ws + WS_WDN);
    F.MOD = (float*)(ws + WS_MOD); F.ROPE = (float*)(ws + WS_ROPE); F.LSE = (float*)(ws + WS_LSE); F.RS1 = (float*)(ws + WS_LSE);
    F.XN = (bf16*)(ws + WS_XN); F.PROJ = (bf16*)(ws + WS_PROJ); F.MIXED = (bf16*)(ws + WS_MIXED); F.PART = (bf16*)(ws + WS_PART); F.HB = (bf16*)(ws + WS_H); F.Y1 = (bf16*)(ws + WS_Y); F.X1 = (float*)(ws + WS_X1); F.Y2 = (bf16*)(ws + WS_Y2);
    const int lo = args.ph_lo, hi = args.ph_hi;
    unsigned* barw = (unsigned*)(ws + WS_CTL);
    volatile LAS unsigned* bst = (volatile LAS unsigned*)(F.lds + 8 * 18432 + 64);
    if (F.tid < 2) bst[F.tid] = 0u;
    if (hi - lo > 1 && blockIdx.x == 0) for (int i = F.tid; i < XCD_BAR_WORDS; i += NWAVES * 64) __hip_atomic_store(barw + i, 0u, __ATOMIC_RELAXED, __HIP_MEMORY_SCOPE_AGENT);
    __syncthreads();
    XcdBarrier bar; bar.bar = barw; bar.x = 0; bar.st = bst;
    if (hi - lo > 1) { grid.sync(); bar = xcd_barrier_post(barw, bst); }
#define IN(k) (lo <= (k) && (k) < hi)
#define SEAM0() SEAM(0)
#define SEAM(k) do { if (IN(k) && IN((k) + 1)) xcd_barrier(bar); } while (0)

    if (IN(0)) { p0_prologue(F); } SEAM0();
    if (IN(1)) { p1_prenorm(F); } SEAM(1);
    if (IN(2)) {
        pg8::Gemm g{F.XN, F.Win_t, M, INW, D}; pg8::StaticOrder S; S.init(M, INW, F.G, (int)blockIdx.x);
        pg8::EpiProj E{F.PROJ, INW, F.ROPE};
        pg8::gemm_phase<pg8::EpiProj, pg8::StaticOrder, PG8_ALIGN, PG8_SP2>(F.lds, g, S, E);
    } SEAM(2);
    if (IN(3)) { attn_phase(F); } SEAM(3);
    if (IN(4)) { p4_combine(F); } SEAM(4);
    if (IN(5)) {
        pg8::Gemm g{F.MIXED, F.Wout_t, M, D, D}; pg8::StaticOrder S; S.init(M, D, F.G, (int)blockIdx.x);
        pg8::EpiBf E{F.Y1, D};
        pg8::gemm_phase<pg8::EpiBf, pg8::StaticOrder, PG8_ALIGN, PG8_SP2>(F.lds, g, S, E);
    } SEAM(5);
    if (IN(6)) { p6_mid(F); } SEAM(6);
    if (IN(7)) {
        pg8::Gemm g{F.XN, F.Wup_t, M, FF, D}; pg8::StaticOrder S; S.init(M, FF, F.G, (int)blockIdx.x);
        pg8::EpiSqRelu E{F.HB, FF};
        pg8::gemm_phase<pg8::EpiSqRelu, pg8::StaticOrder, PG8_ALIGN, PG8_SP2>(F.lds, g, S, E);
    } SEAM(7);
    if (IN(8)) {
        pg8::Gemm g{F.HB, F.Wdn_t, M, D, FF}; pg8::StaticOrder S; S.init(M, D, F.G, (int)blockIdx.x);
        pg8::EpiBf E{F.Y2, D};
        pg8::gemm_phase<pg8::EpiBf, pg8::StaticOrder, PG8_ALIGN, PG8_SP2>(F.lds, g, S, E);
    } SEAM(8);
    if (IN(9)) { p9_final(F); }
#undef IN
#undef SEAM
#undef SEAM0
}

extern "C" void kernel_launch(void* const* d_in, const int* in_sizes, int n_in, void* d_out, int out_size, void* d_ws, size_t ws_size, hipStream_t stream) {
    static int grid = 0;
    if (grid == 0) {
        if (n_in != 16 || in_sizes[0] != M * D || out_size != M * D || ws_size < WS_END) { fprintf(stderr, "kernel_launch: unexpected shapes (n_in %d, in0 %d, out %d, ws %zu); nothing launched\n", n_in, n_in > 0 ? in_sizes[0] : -1, out_size, ws_size); grid = -1; return; }
        int dev = 0, cus = 0, per_cu = 0;
        if (hipGetDevice(&dev) != hipSuccess || hipDeviceGetAttribute(&cus, hipDeviceAttributeMultiprocessorCount, dev) != hipSuccess) { grid = -1; return; }
        if (hipFuncSetAttribute((const void*)fwd_kernel, hipFuncAttributeMaxDynamicSharedMemorySize, LDS_BYTES) != hipSuccess) { fprintf(stderr, "kernel_launch: hipFuncSetAttribute failed\n"); grid = -1; return; }
        if (hipOccupancyMaxActiveBlocksPerMultiprocessor(&per_cu, (const void*)fwd_kernel, NWAVES * 64, LDS_BYTES) != hipSuccess || per_cu < 1) { fprintf(stderr, "kernel_launch: occupancy query says %d\n", per_cu); per_cu = 1; }
        (void)hipGetLastError();
        grid = cus * per_cu;
    }
    if (grid < 0) return;
    Args a{};
    for (int i = 0; i < 16; ++i) a.in[i] = d_in[i];
    a.out = (float*)d_out; a.ws = (unsigned char*)d_ws;
#if MK_COOP
    a.ph_lo = 0; a.ph_hi = NPH;
    void* kargs[] = {&a};
    hipError_t e = hipLaunchCooperativeKernel((const void*)fwd_kernel, dim3(grid), dim3(NWAVES * 64), kargs, LDS_BYTES, stream);
    if (e != hipSuccess) fprintf(stderr, "kernel_launch: cooperative launch failed: %s (grid %d)\n", hipGetErrorString(e), grid);
#else
    for (int ph = 0; ph < NPH; ++ph) { a.ph_lo = ph; a.ph_hi = ph + 1; const int reps = (ph == MK_DUP) ? 2 : 1;
        for (int rp = 0; rp < reps; ++rp) hipLaunchKernelGGL(fwd_kernel, dim3(grid), dim3(NWAVES * 64), LDS_BYTES, stream, a); }
#endif
}
```

```cpp
#include <hip/hip_cooperative_groups.h>
#include <hip/hip_runtime.h>
#include <cstdio>
#include <cstdint>
namespace pg8 {
#define PG8_LAS __attribute__((address_space(3)))
typedef unsigned short bf16_t;
typedef short bf16x8 __attribute__((ext_vector_type(8)));
typedef float f32x4 __attribute__((ext_vector_type(4)));
typedef unsigned u32x4 __attribute__((ext_vector_type(4)));
constexpr int BM = 256, BK = 64, HALF = 128, HTB = HALF * BK * 2  , STAGE_BYTES = 8 * HTB, NXCD = 8, WGM = 8;

__host__ __device__ __forceinline__ int lds_byte(int r, int c) { const int st = (r >> 4) * 2 + (c >> 5), rr = r & 15, cc = c & 31, ob = rr * 64 + cc * 2; return st * 1024 + (ob ^ (((ob >> 9) & 1) << 5)); }
__host__ __device__ __forceinline__ void stage_rc(int b, int& R, int& C) { const int st = b / 1024, sb = b % 1024, swz = sb ^ (((sb >> 9) & 1) << 5); R = (st >> 1) * 16 + swz / 64; C = (st & 1) * 32 + (swz % 64) / 2; }
__host__ __device__ __forceinline__ int perm32(int rho) { const int n = rho >> 4, i = rho & 15; return 8 * (i >> 2) + 4 * n + (i & 3); }

struct Unit { int pm, pn; };
struct Gemm { const bf16_t* A; const bf16_t* Bt; int M, N, K; };

struct StaticOrder {
    int nM, nN, nwg, G, c;
    __host__ __device__ void init(int M, int N, int G_, int c_) { nM = M / BM; nN = N / BM; nwg = nM * nN; G = G_; c = c_; }
    __host__ __device__ bool next(int i, Unit& u) const {
        const long L = (long)i * G + c; if (L >= nwg) return false;
        int wgid = (int)L; { const int q = nwg / NXCD, r = nwg % NXCD, xcd = wgid % NXCD, off = wgid / NXCD; wgid = (xcd < r ? xcd * (q + 1) : r * (q + 1) + (xcd - r) * q) + off; }
        const int nig = WGM * nN, gid = wgid / nig, fm = gid * WGM, gsz = (nM - fm) < WGM ? (nM - fm) : WGM;
        u.pm = fm + ((wgid % nig) % gsz); u.pn = (wgid % nig) / gsz; return true;
    }
    __device__ __forceinline__ void a_ready(const Unit&) const {}
    __device__ __forceinline__ void done(const Unit&) const {}
};

__device__ __forceinline__ unsigned cvt_pk_bf16(float lo, float hi) { unsigned r; asm volatile("v_cvt_pk_bf16_f32 %0, %1, %2" : "=v"(r) : "v"(lo), "v"(hi)); return r; }
typedef float f32x2 __attribute__((ext_vector_type(2)));
__device__ __forceinline__ f32x2 gelu_pk(f32x2 v) {
    const f32x2 av = __builtin_elementwise_abs(v), d = av * 0.2316418882f + 1.0f;
    f32x2 t; t.x = __builtin_amdgcn_rcpf(d.x); t.y = __builtin_amdgcn_rcpf(d.y);
    f32x2 q = t * 0.5307027145f + (-0.7265760135f); q = q * t + 0.7107068705f; q = q * t + (-0.142248368f); q = q * t + 0.127414796f; q = q * t;
    const f32x2 s = (v * v) * (-0.72134752044f);
    f32x2 e; e.x = __builtin_amdgcn_exp2f(s.x); e.y = __builtin_amdgcn_exp2f(s.y);
    const f32x2 m = v * (q * e), r = v - m;
    f32x2 o; o.x = v.x < 0.f ? m.x : r.x; o.y = v.y < 0.f ? m.y : r.y; return o;
}

template <int ACT  > struct EpiBf16 {
    static constexpr bool PERM = true, AFTER_DRAIN = false; static_assert(ACT == 0 || ACT == 1, "EpiBf16: ACT is 0 (none) or 1 (gelu_pk)");
    bf16_t* O; int ldc; const float* bias; int split_cols; size_t split_stride; float scale0;
    __device__ __forceinline__ void operator()(const f32x4 (&acc)[2][2][4][2], const Unit& u, int wr, int wc, int fr, int fq) const {
        const int row0 = u.pm * BM + wr * 64 + fr; int colt = u.pn * BM; bf16_t* base = O;
        float sc = 1.f; if (split_cols) { const int t = colt / split_cols; base += (size_t)t * split_stride; colt -= t * split_cols; if (t == 0) sc = scale0; }
        const int col0 = colt + wc * 32 + 8 * fq, bcol0 = u.pn * BM + wc * 32 + 8 * fq;
        f32x4 bv[2][2];
#pragma unroll
        for (int bj = 0; bj < 2; ++bj)
#pragma unroll
            for (int n = 0; n < 2; ++n) bv[bj][n] = bias ? *(const f32x4*)(bias + bcol0 + bj * HALF + 4 * n) : (f32x4){0.f, 0.f, 0.f, 0.f};
#pragma unroll
        for (int ai = 0; ai < 2; ++ai)
#pragma unroll
            for (int m = 0; m < 4; ++m) { bf16_t* rowp = base + (size_t)(row0 + ai * HALF + m * 16) * ldc + col0;
#pragma unroll
                for (int bj = 0; bj < 2; ++bj) { f32x4 v0 = acc[ai][bj][m][0] + bv[bj][0], v1 = acc[ai][bj][m][1] + bv[bj][1];
                    if (ACT == 1) { f32x2 a = gelu_pk((f32x2){v0[0], v0[1]}), b = gelu_pk((f32x2){v0[2], v0[3]}), c = gelu_pk((f32x2){v1[0], v1[1]}), d = gelu_pk((f32x2){v1[2], v1[3]});
                        v0 = (f32x4){a.x, a.y, b.x, b.y}; v1 = (f32x4){c.x, c.y, d.x, d.y}; }
                    v0 = v0 * sc; v1 = v1 * sc; u32x4 w; w.x = cvt_pk_bf16(v0[0], v0[1]); w.y = cvt_pk_bf16(v0[2], v0[3]); w.z = cvt_pk_bf16(v1[0], v1[1]); w.w = cvt_pk_bf16(v1[2], v1[3]);
                    *(u32x4*)(rowp + bj * HALF) = w; } }
    }
};

struct EpiProj {
    static constexpr bool PERM = true, AFTER_DRAIN = false;
    bf16_t* O; int ldc; const float* rope;
    __device__ __forceinline__ void operator()(const f32x4 (&acc)[2][2][4][2], const Unit& u, int wr, int wc, int fr, int fq) const {
        const int row0 = u.pm * BM + wr * 64 + fr; const int colt = u.pn * BM; const int col0 = colt + wc * 32 + 8 * fq;
        const bool wrot = (wc & 1) == 0;
        const float sgn = (fq == 0) ? -1.f : 1.f;
#pragma unroll
        for (int ai = 0; ai < 2; ++ai)
#pragma unroll
            for (int m = 0; m < 4; ++m) {
                const int row = row0 + ai * HALF + m * 16;
                bf16_t* rowp = O + ((size_t)(col0 >> 6) * 32768 + row) * 64 + (col0 & 63);
                f32x4 c0v = {1.f, 1.f, 1.f, 1.f}, c1v = c0v, s0v = {0.f, 0.f, 0.f, 0.f}, s1v = s0v;
                if (wrot) { const f32x4* rp = (const f32x4*)(rope + (size_t)row * 16); c0v = rp[0]; c1v = rp[1]; s0v = rp[2] * sgn; s1v = rp[3] * sgn; }
#pragma unroll
                for (int bj = 0; bj < 2; ++bj) {
                    f32x4 v0 = acc[ai][bj][m][0], v1 = acc[ai][bj][m][1];
                    const int cb = colt + bj * HALF;
                    const bool rot = wrot && (cb < 640 || (cb >= 768 && cb < 1792));
                    if (rot) {
                        f32x4 p0, p1;
#pragma unroll
                        for (int j = 0; j < 4; ++j) { p0[j] = __shfl_xor(v0[j], 16); p1[j] = __shfl_xor(v1[j], 16); }
                        if (fq < 2) { v0 = v0 * c0v + p0 * s0v; v1 = v1 * c1v + p1 * s1v; }
                    }
                    u32x4 w; w.x = cvt_pk_bf16(v0[0], v0[1]); w.y = cvt_pk_bf16(v0[2], v0[3]); w.z = cvt_pk_bf16(v1[0], v1[1]); w.w = cvt_pk_bf16(v1[2], v1[3]);
                    *(u32x4*)(rowp + (size_t)bj * 2 * 32768 * 64) = w;
                }
            }
    }
};
struct EpiSqRelu {
    static constexpr bool PERM = true, AFTER_DRAIN = false;
    bf16_t* O; int ldc;
    __device__ __forceinline__ void operator()(const f32x4 (&acc)[2][2][4][2], const Unit& u, int wr, int wc, int fr, int fq) const {
        const int row0 = u.pm * BM + wr * 64 + fr; const int col0 = u.pn * BM + wc * 32 + 8 * fq;
#pragma unroll
        for (int ai = 0; ai < 2; ++ai)
#pragma unroll
            for (int m = 0; m < 4; ++m) { bf16_t* rowp = O + (size_t)(row0 + ai * HALF + m * 16) * ldc + col0;
#pragma unroll
                for (int bj = 0; bj < 2; ++bj) { f32x4 v0 = acc[ai][bj][m][0], v1 = acc[ai][bj][m][1];
                    v0 = __builtin_elementwise_max(v0, (f32x4){0.f, 0.f, 0.f, 0.f}); v1 = __builtin_elementwise_max(v1, (f32x4){0.f, 0.f, 0.f, 0.f}); v0 = v0 * v0; v1 = v1 * v1;
                    u32x4 w; w.x = cvt_pk_bf16(v0[0], v0[1]); w.y = cvt_pk_bf16(v0[2], v0[3]); w.z = cvt_pk_bf16(v1[0], v1[1]); w.w = cvt_pk_bf16(v1[2], v1[3]);
                    *(u32x4*)(rowp + bj * HALF) = w; } }
    }
};
struct EpiBf {
    static constexpr bool PERM = true, AFTER_DRAIN = false;
    bf16_t* O; int ldc;
    __device__ __forceinline__ void operator()(const f32x4 (&acc)[2][2][4][2], const Unit& u, int wr, int wc, int fr, int fq) const {
        const int row0 = u.pm * BM + wr * 64 + fr; const int col0 = u.pn * BM + wc * 32 + 8 * fq;
#pragma unroll
        for (int ai = 0; ai < 2; ++ai)
#pragma unroll
            for (int m = 0; m < 4; ++m) { bf16_t* rowp = O + (size_t)(row0 + ai * HALF + m * 16) * ldc + col0;
#pragma unroll
                for (int bj = 0; bj < 2; ++bj) { const f32x4 v0 = acc[ai][bj][m][0], v1 = acc[ai][bj][m][1];
                    u32x4 w; w.x = cvt_pk_bf16(v0[0], v0[1]); w.y = cvt_pk_bf16(v0[2], v0[3]); w.z = cvt_pk_bf16(v1[0], v1[1]); w.w = cvt_pk_bf16(v1[2], v1[3]);
                    *(u32x4*)(rowp + bj * HALF) = w; } }
    }
};
struct EpiF32 {
    static constexpr bool PERM = true, AFTER_DRAIN = false;
    float* O; int ldc;
    __device__ __forceinline__ void operator()(const f32x4 (&acc)[2][2][4][2], const Unit& u, int wr, int wc, int fr, int fq) const {
        const int row0 = u.pm * BM + wr * 64 + fr; const int col0 = u.pn * BM + wc * 32 + 8 * fq;
#pragma unroll
        for (int ai = 0; ai < 2; ++ai)
#pragma unroll
            for (int m = 0; m < 4; ++m) { float* rowp = O + (size_t)(row0 + ai * HALF + m * 16) * ldc + col0;
#pragma unroll
                for (int bj = 0; bj < 2; ++bj) { *(f32x4*)(rowp + bj * HALF) = acc[ai][bj][m][0]; *(f32x4*)(rowp + bj * HALF + 4) = acc[ai][bj][m][1]; } }
    }
};
template <class Epi, class Sched, bool ALIGN_EPI = false, bool SP2 = false>
__device__ __forceinline__ void gemm_phase(PG8_LAS unsigned char* lds, const Gemm g, const Sched& S, const Epi& E) {
    const int tid = threadIdx.x, wid = __builtin_amdgcn_readfirstlane(tid >> 6), lane = tid & 63, wr = wid >> 2, wc = wid & 3, fr = lane & 15, fq = lane >> 4;
    const int K = g.K, nt = K / BK;
    unsigned voffA[2], voffB[2];
#pragma unroll
    for (int i = 0; i < 2; ++i) { int R, C; stage_rc(tid * 16 + i * 8192, R, C); const int Rb = Epi::PERM ? ((R & ~31) + perm32(R & 31)) : R;
        voffA[i] = (unsigned)(R * K + C) * 2u; voffB[i] = (unsigned)(Rb * K + C) * 2u; }
    const size_t kstep = (size_t)(BK * 2);
    const size_t hstep = (size_t)HALF * K * 2;
    const size_t tstep = 2 * hstep;
    const unsigned ldsw = (unsigned)wid * 1024u;
    const int aoff = lds_byte(wr * 64 + fr, fq * 8), boff = lds_byte(wc * 32 + fr, fq * 8);
#define PG8_SA(b, h) (((b) * 2 + (h)) * HTB)
#define PG8_SB(b, h) ((4 + (b) * 2 + (h)) * HTB)
#define PG8_STAGE(bufoff, gbase, voff) do { _Pragma("unroll") for (int _i = 0; _i < 2; ++_i) \
        __builtin_amdgcn_global_load_lds((const unsigned*)((const char*)(gbase) + (voff)[_i]), (PG8_LAS unsigned*)(lds + (bufoff) + ldsw + _i * 8192), 16, 0, 0); } while (0)
#define PG8_LDA(dst, b, h) do { _Pragma("unroll") for (int m = 0; m < 4; ++m) _Pragma("unroll") for (int k = 0; k < 2; ++k) dst[m][k] = *(const PG8_LAS bf16x8*)(lds + PG8_SA(b, h) + aoff + m * 2048 + k * 1024); } while (0)
#define PG8_LDB(dst, b, h) do { _Pragma("unroll") for (int n = 0; n < 2; ++n) _Pragma("unroll") for (int k = 0; k < 2; ++k) dst[n][k] = *(const PG8_LAS bf16x8*)(lds + PG8_SB(b, h) + boff + n * 2048 + k * 1024); } while (0)
#define PG8_MMA(ai, bj, At, Bt) do { __builtin_amdgcn_s_setprio(1); _Pragma("unroll") for (int m = 0; m < 4; ++m) _Pragma("unroll") for (int n = 0; n < 2; ++n) _Pragma("unroll") for (int k = 0; k < 2; ++k) \
        acc[ai][bj][m][n] = __builtin_amdgcn_mfma_f32_16x16x32_bf16(Bt[n][k], At[m][k], acc[ai][bj][m][n], 0, 0, 0); __builtin_amdgcn_s_setprio(0); } while (0)
#define PG8_WAIT_V(n) asm volatile("s_waitcnt vmcnt(" #n ")" ::: "memory")
#define PG8_WAIT_L(n) asm volatile("s_waitcnt lgkmcnt(" #n ")" ::: "memory")
#define PG8_BAR __builtin_amdgcn_s_barrier()
#define PG8_SCHED __builtin_amdgcn_sched_barrier(0)
    Unit cur, nxt; int ui = 0;
    if (!S.next(0, cur)) return;
    f32x4 acc[2][2][4][2];
#pragma unroll
    for (int a = 0; a < 2; ++a)
#pragma unroll
        for (int b = 0; b < 2; ++b)
#pragma unroll
            for (int m = 0; m < 4; ++m)
#pragma unroll
                for (int n = 0; n < 2; ++n) acc[a][b][m][n] = (f32x4){0.f, 0.f, 0.f, 0.f};
    bf16x8 At[4][2], B0[2][2], B1[2][2];
    const char* cA = (const char*)g.A + (size_t)cur.pm * tstep; const char* cB = (const char*)g.Bt + (size_t)cur.pn * tstep;
    S.a_ready(cur);
    if constexpr (SP2) {
        PG8_STAGE(PG8_SB(0, 0), cB, voffB); PG8_STAGE(PG8_SB(0, 1), cB + hstep, voffB); PG8_STAGE(PG8_SA(0, 0), cA, voffA); PG8_STAGE(PG8_SA(0, 1), cA + hstep, voffA);
        if (wr == 1) PG8_BAR;
        PG8_WAIT_V(2); PG8_BAR;
        PG8_STAGE(PG8_SB(1, 0), cB + kstep, voffB); PG8_STAGE(PG8_SA(1, 0), cA + kstep, voffA); PG8_STAGE(PG8_SB(1, 1), cB + hstep + kstep, voffB);
        PG8_WAIT_V(6); PG8_BAR;
    } else {
        PG8_STAGE(PG8_SB(0, 0), cB, voffB); PG8_STAGE(PG8_SA(0, 0), cA, voffA); PG8_STAGE(PG8_SB(0, 1), cB + hstep, voffB); PG8_STAGE(PG8_SA(0, 1), cA + hstep, voffA);
        if (wr == 1) PG8_BAR;
        PG8_WAIT_V(4); PG8_BAR;
        PG8_STAGE(PG8_SB(1, 0), cB + kstep, voffB); PG8_STAGE(PG8_SA(1, 0), cA + kstep, voffA); PG8_STAGE(PG8_SB(1, 1), cB + hstep + kstep, voffB);
        PG8_WAIT_V(6); PG8_BAR;
    }
    for (;;) {
        const bool has_next = S.next(ui + 1, nxt);
        const char* nA = has_next ? (const char*)g.A + (size_t)nxt.pm * tstep : cA; const char* nB = has_next ? (const char*)g.Bt + (size_t)nxt.pn * tstep : cB;
        for (int t = 0; t < nt; t += 2) {
            const bool last = (t == nt - 2);
            const char* a1 = cA + (size_t)(t + 1) * kstep;
            const char* a2 = last ? nA : cA + (size_t)(t + 2) * kstep; const char* b2 = last ? nB : cB + (size_t)(t + 2) * kstep;
            const char* a3 = a2 + kstep; const char* b3 = b2 + kstep;
            if (last && has_next) S.a_ready(nxt);
            if constexpr (SP2) {
            PG8_LDB(B0, 0, 0); PG8_LDB(B1, 0, 1); PG8_SCHED; PG8_LDA(At, 0, 0); PG8_STAGE(PG8_SA(1, 1), a1 + hstep, voffA);
            PG8_WAIT_V(8); PG8_WAIT_L(0); PG8_BAR; PG8_MMA(0, 0, At, B0); PG8_MMA(0, 1, At, B1); PG8_BAR; PG8_SCHED;
            PG8_LDA(At, 0, 1); PG8_STAGE(PG8_SB(0, 0), b2, voffB); PG8_STAGE(PG8_SB(0, 1), b2 + hstep, voffB); PG8_STAGE(PG8_SA(0, 0), a2, voffA);
            PG8_WAIT_V(8); PG8_WAIT_L(0); PG8_BAR; PG8_MMA(1, 0, At, B0); PG8_MMA(1, 1, At, B1); PG8_BAR; PG8_SCHED;
            PG8_LDB(B0, 1, 0); PG8_LDB(B1, 1, 1); PG8_SCHED; PG8_LDA(At, 1, 0); PG8_STAGE(PG8_SA(0, 1), a2 + hstep, voffA);
            PG8_WAIT_V(8); PG8_WAIT_L(0); PG8_BAR; PG8_MMA(0, 0, At, B0); PG8_MMA(0, 1, At, B1); PG8_BAR; PG8_SCHED;
            PG8_LDA(At, 1, 1); PG8_STAGE(PG8_SB(1, 0), b3, voffB); PG8_STAGE(PG8_SB(1, 1), b3 + hstep, voffB); PG8_STAGE(PG8_SA(1, 0), a3, voffA);
            PG8_WAIT_V(8); PG8_WAIT_L(0); PG8_BAR; PG8_MMA(1, 0, At, B0); PG8_MMA(1, 1, At, B1); PG8_BAR; PG8_SCHED;
            } else {
            PG8_LDB(B0, 0, 0); PG8_SCHED; PG8_LDA(At, 0, 0); PG8_STAGE(PG8_SA(1, 1), a1 + hstep, voffA);
            PG8_WAIT_L(8); PG8_BAR; PG8_WAIT_L(0); PG8_MMA(0, 0, At, B0); PG8_BAR; PG8_SCHED;
            PG8_LDB(B1, 0, 1); PG8_STAGE(PG8_SB(0, 0), b2, voffB);
            PG8_BAR; PG8_WAIT_L(0); PG8_MMA(0, 1, At, B1); PG8_BAR;
            PG8_LDA(At, 0, 1); PG8_STAGE(PG8_SA(0, 0), a2, voffA);
            PG8_BAR; PG8_WAIT_L(0); PG8_MMA(1, 0, At, B0); PG8_BAR; PG8_SCHED;
            PG8_STAGE(PG8_SB(0, 1), b2 + hstep, voffB);
            PG8_WAIT_V(6); PG8_BAR; PG8_MMA(1, 1, At, B1); PG8_BAR;
            PG8_LDB(B0, 1, 0); PG8_SCHED; PG8_LDA(At, 1, 0); PG8_STAGE(PG8_SA(0, 1), a2 + hstep, voffA);
            PG8_WAIT_L(8); PG8_BAR; PG8_WAIT_L(0); PG8_MMA(0, 0, At, B0); PG8_BAR; PG8_SCHED;
            PG8_LDB(B1, 1, 1); PG8_STAGE(PG8_SB(1, 0), b3, voffB);
            PG8_BAR; PG8_WAIT_L(0); PG8_MMA(0, 1, At, B1); PG8_BAR;
            PG8_LDA(At, 1, 1); PG8_STAGE(PG8_SA(1, 0), a3, voffA);
            PG8_BAR; PG8_WAIT_L(0); PG8_MMA(1, 0, At, B0); PG8_BAR; PG8_SCHED;
            PG8_STAGE(PG8_SB(1, 1), b3 + hstep, voffB);
            PG8_WAIT_V(6); PG8_BAR; PG8_MMA(1, 1, At, B1); PG8_BAR;
            }
        }
        if constexpr (ALIGN_EPI) { if (wr == 0) PG8_BAR; }
        if constexpr (!Epi::AFTER_DRAIN) { E(acc, cur, wr, wc, fr, fq); S.done(cur); }
        if (!has_next) break;
#pragma unroll
        for (int a = 0; a < 2; ++a)
#pragma unroll
            for (int b = 0; b < 2; ++b)
#pragma unroll
                for (int m = 0; m < 4; ++m)
#pragma unroll
                    for (int n = 0; n < 2; ++n) acc[a][b][m][n] = (f32x4){0.f, 0.f, 0.f, 0.f};
        cur = nxt; cA = nA; cB = nB; ++ui;
        if constexpr (ALIGN_EPI) { if (wr == 1) PG8_BAR; }
    }
    PG8_WAIT_V(0);
    if constexpr (!ALIGN_EPI) { if (wr == 0) PG8_BAR; }
    PG8_BAR;
    if constexpr (Epi::AFTER_DRAIN) { E.fused(acc, cur, wr, wc, fr, fq, lds, wid, lane); S.done(cur); }
#undef PG8_SA
#undef PG8_SB
#undef PG8_STAGE
#undef PG8_LDA
#undef PG8_LDB
#undef PG8_MMA
#undef PG8_WAIT_V
#undef PG8_WAIT_L
#undef PG8_BAR
#undef PG8_SCHED
}
}
#ifndef PG8_SP2
#define PG8_SP2 true
#endif
#ifndef PG8_ALIGN
#define PG8_ALIGN true
#endif
#ifndef MK_DUP
#define MK_DUP -1
#endif
#ifndef MK_COOP
#define MK_COOP 1
#endif

#define GAS __attribute__((address_space(1)))
#define LAS __attribute__((address_space(3)))
typedef unsigned short bf16;
typedef unsigned v4u __attribute__((ext_vector_type(4)));
typedef unsigned v2u __attribute__((ext_vector_type(2)));
typedef float f32x4 __attribute__((ext_vector_type(4)));
typedef float f32x16 __attribute__((ext_vector_type(16)));
typedef short bf16x8 __attribute__((ext_vector_type(8)));
typedef short s16x4 __attribute__((ext_vector_type(4)));
#define LDS_WAIT() asm volatile("s_waitcnt lgkmcnt(0)" ::: "memory")
__device__ __forceinline__ unsigned pk2(float lo, float hi) { return pg8::cvt_pk_bf16(lo, hi); }
__device__ __forceinline__ float bf_lo(unsigned w) { return __builtin_bit_cast(float, w << 16); }
__device__ __forceinline__ float bf_hi(unsigned w) { return __builtin_bit_cast(float, w & 0xffff0000u); }

constexpr int NWAVES = 8;
constexpr int BATCH = 16, SEQ = 2048, D = 1024, FF = 4096, INW = 2304, M = BATCH * SEQ;
constexpr int NMOD = 6 * D;
constexpr float EPS = 1e-6f;
constexpr int NPH = 10;
constexpr size_t MiB = 1u << 20;
constexpr size_t WS_CTL = 0, WS_WIN = 2 * MiB, WS_WOUT = 7 * MiB, WS_WUP = 9 * MiB, WS_WDN = 17 * MiB, WS_MOD = 25 * MiB, WS_ROPE = 26 * MiB, WS_LSE = 28 * MiB;
constexpr size_t WS_XN = 36 * MiB, WS_PROJ = 100 * MiB, WS_MIXED = 244 * MiB, WS_PART = 308 * MiB, WS_H = 100 * MiB, WS_Y = 420 * MiB  , WS_X1 = 356 * MiB  , WS_Y2 = 36 * MiB, WS_END = 484 * MiB;
constexpr int LDS_BYTES = 155648;

struct Frame {
    LAS unsigned char* lds;
    int tid, lane, wave, G;
    const float *x, *c, *w_ada, *b_ada, *g_attn_pre, *g_attn_post, *w_in, *sink_a, *g_mix_a, *g_mix_b, *w_out, *g_mlp_pre, *g_mlp_post, *w_up, *w_down;
    const int* positions;
    float* out;
    bf16 *Win_t, *Wout_t, *Wup_t, *Wdn_t, *XN, *PROJ, *MIXED, *PART, *HB;
    float *MOD, *ROPE, *LSE, *X1, *RS1; bf16 *Y1, *Y2;
};

__device__ __forceinline__ float wave_sum(float v) {
#pragma unroll
    for (int o = 1; o < 64; o <<= 1) v += __shfl_xor(v, o);
    return v;
}
__device__ __forceinline__ void p0_transpose_item(const float* W, int K, int N, bf16* WT, LAS float* scr, int item, int lane) {
    const int nblk = N / 32, kb = item / nblk, nb = item % nblk, k0 = 64 * kb, n0 = 32 * nb;
    float wv[32];
#pragma unroll
    for (int i = 0; i < 32; ++i) wv[i] = __builtin_nontemporal_load(W + (size_t)(k0 + 2 * i + (lane >> 5)) * N + n0 + (lane & 31));
#pragma unroll
    for (int i = 0; i < 32; ++i) scr[(2 * i + (lane >> 5)) * 33 + (lane & 31)] = wv[i];
    LDS_WAIT(); asm volatile("" ::: "memory");
    const int c = lane & 7;
#pragma unroll
    for (int j = 0; j < 4; ++j) { const int n = (lane >> 3) + 8 * j; const LAS float* s = scr + (8 * c) * 33 + n;
        v4u o; o.x = pk2(s[0 * 33], s[1 * 33]); o.y = pk2(s[2 * 33], s[3 * 33]); o.z = pk2(s[4 * 33], s[5 * 33]); o.w = pk2(s[6 * 33], s[7 * 33]);
        *(GAS v4u*)(WT + (size_t)(n0 + n) * K + k0 + 8 * c) = o; }
    LDS_WAIT(); asm volatile("" ::: "memory");
}
__device__ __forceinline__ double inv_freq_d(int i) {
    switch (i) { case 0: return 1.0; case 1: return 0.19392274474868576; case 2: return 0.03760603093086393; case 3: return 0.007292664737217109;
                 case 4: return 0.001414213562373095; case 5: return 0.0002742481756762073; case 6: return 5.318295896944988e-05; default: return 1.031338537721246e-05; }
}
__device__ __forceinline__ void sincos_d(double ang, float& cs, float& sn) {
    const double t = ang * 0.15915494309189535;
    const double fr = t - __builtin_rint(t);
    const double kq = __builtin_rint(fr * 4.0);
    const double y = (fr - kq * 0.25) * 6.283185307179586;
    const double y2 = y * y;
    double s = -1.0 / 1307674368000.0; s = s * y2 + 1.0 / 6227020800.0; s = s * y2 - 1.0 / 39916800.0; s = s * y2 + 1.0 / 362880.0; s = s * y2 - 1.0 / 5040.0; s = s * y2 + 1.0 / 120.0; s = s * y2 - 1.0 / 6.0; s = s * y2 + 1.0; s = s * y;
    double c = 1.0 / 87178291200.0; c = c * y2 - 1.0 / 479001600.0; c = c * y2 + 1.0 / 3628800.0; c = c * y2 - 1.0 / 40320.0; c = c * y2 + 1.0 / 720.0; c = c * y2 - 1.0 / 24.0; c = c * y2 + 0.5; c = 1.0 - c * y2;
    const int k = ((int)kq) & 3;
    double co = c, so = s;
    if (k == 1) { co = -s; so = c; } else if (k == 2) { co = -c; so = -s; } else if (k == 3) { co = s; so = -c; }
    cs = (float)co; sn = (float)so;
}

__device__ __forceinline__ void p0_prologue(Frame& F) {
    if ((int)blockIdx.x < NMOD / 64) {
        LAS float* condT = (LAS float*)F.lds;
        LAS float* red = (LAS float*)(F.lds + 65536);
        { float cvv[32];
#pragma unroll
          for (int j = 0; j < 32; ++j) cvv[j] = F.c[F.tid + j * (NWAVES * 64)];
#pragma unroll
          for (int j = 0; j < 32; ++j) { const int idx = F.tid + j * (NWAVES * 64), b = idx >> 10, k = idx & 1023; condT[k * 16 + b] = cvv[j] / (1.f + __expf(-cvv[j])); } }
        __syncthreads();
        for (int it = blockIdx.x; it < NMOD / 64; it += F.G) {
            const int n = it * 64 + F.lane, k0 = F.wave * 128;
            float acc[16];
#pragma unroll
            for (int b = 0; b < 16; ++b) acc[b] = 0.f;
#pragma unroll 1
            for (int kb = k0; kb < k0 + 128; kb += 16) {
                const float* wp = F.w_ada + (size_t)kb * NMOD + n;
                f32x4 w0, w1, w2, w3;
                w0[0] = wp[0]; w0[1] = wp[NMOD]; w0[2] = wp[2 * NMOD]; w0[3] = wp[3 * NMOD]; w1[0] = wp[4 * NMOD]; w1[1] = wp[5 * NMOD]; w1[2] = wp[6 * NMOD]; w1[3] = wp[7 * NMOD];
                w2[0] = wp[8 * NMOD]; w2[1] = wp[9 * NMOD]; w2[2] = wp[10 * NMOD]; w2[3] = wp[11 * NMOD]; w3[0] = wp[12 * NMOD]; w3[1] = wp[13 * NMOD]; w3[2] = wp[14 * NMOD]; w3[3] = wp[15 * NMOD];
                asm volatile("" : "+v"(w0), "+v"(w1), "+v"(w2), "+v"(w3));
#pragma unroll
                for (int j = 0; j < 16; ++j) { const float w = j < 4 ? w0[j & 3] : (j < 8 ? w1[j & 3] : (j < 12 ? w2[j & 3] : w3[j & 3]));
                    const LAS f32x4* cp = (const LAS f32x4*)(condT + (kb + j) * 16);
#pragma unroll
                    for (int q = 0; q < 4; ++q) { const f32x4 cv = cp[q]; acc[4 * q + 0] += cv[0] * w; acc[4 * q + 1] += cv[1] * w; acc[4 * q + 2] += cv[2] * w; acc[4 * q + 3] += cv[3] * w; }
                    asm volatile("" : "+v"(acc[0]), "+v"(acc[15])); }
            }
#pragma unroll
            for (int b = 0; b < 16; ++b) red[(F.wave * 16 + b) * 64 + F.lane] = acc[b];
            __syncthreads();
            for (int o = F.tid; o < 1024; o += NWAVES * 64) { const int b = o >> 6, col = o & 63; float s = 0.f;
#pragma unroll
                for (int w = 0; w < 8; ++w) s += red[(w * 16 + b) * 64 + col];
                F.MOD[b * NMOD + it * 64 + col] = s + F.b_ada[it * 64 + col]; }
            __syncthreads();
        }
    }
    __syncthreads();
    LAS float* scr = (LAS float*)(F.lds + F.wave * 16384);
    const int gw = blockIdx.x * NWAVES + F.wave, NGW = F.G * NWAVES;
    constexpr int I_IN = (D / 64) * (INW / 32), I_OUT = (D / 64) * (D / 32), I_UP = (D / 64) * (FF / 32), I_DN = (FF / 64) * (D / 32);
    constexpr int NITEMS = I_IN + I_OUT + I_UP + I_DN;
    const int TB0 = (F.G == 256) ? NMOD / 64 : 0, tgw = ((int)blockIdx.x - TB0) * NWAVES + F.wave, TNGW = (F.G - TB0) * NWAVES;
    for (int it = ((int)blockIdx.x >= TB0) ? tgw : NITEMS; it < NITEMS; it += TNGW) {
        int r = it;
        if (r < I_IN) { p0_transpose_item(F.w_in, D, INW, F.Win_t, scr, r, F.lane); continue; } r -= I_IN;
        if (r < I_OUT) { p0_transpose_item(F.w_out, D, D, F.Wout_t, scr, r, F.lane); continue; } r -= I_OUT;
        if (r < I_UP) { p0_transpose_item(F.w_up, D, FF, F.Wup_t, scr, r, F.lane); continue; } r -= I_UP;
        p0_transpose_item(F.w_down, FF, D, F.Wdn_t, scr, r, F.lane);
    }
    for (int idx = blockIdx.x * (NWAVES * 64) + F.tid; idx < M * 8; idx += F.G * NWAVES * 64) {
        const int row = idx >> 3, i = idx & 7;
        const float angf = (float)F.positions[row] * (float)inv_freq_d(i);
        float cs, sn; sincos_d((double)angf, cs, sn);
        F.ROPE[row * 16 + i] = cs; F.ROPE[row * 16 + 8 + i] = sn;
    }
}

__device__ __forceinline__ void p1_prenorm(Frame& F) {
    const int gw = blockIdx.x * NWAVES + F.wave, NGW = F.G * NWAVES;
    for (int m0 = 4 * gw; m0 < M; m0 += 4 * NGW) {
        const int b = m0 / SEQ; const float* mod = F.MOD + b * NMOD;
        f32x4 v[4][4]; float s[4] = {0.f, 0.f, 0.f, 0.f};
#pragma unroll
        for (int t = 0; t < 4; ++t) { const f32x4* xr = (const f32x4*)(F.x + (size_t)(m0 + t) * D) + F.lane;
#pragma unroll
            for (int j = 0; j < 4; ++j) v[t][j] = __builtin_nontemporal_load(xr + 64 * j); }
#pragma unroll
        for (int t = 0; t < 4; ++t)
#pragma unroll
            for (int j = 0; j < 4; ++j) s[t] += (v[t][j].x * v[t][j].x + v[t][j].y * v[t][j].y) + (v[t][j].z * v[t][j].z + v[t][j].w * v[t][j].w);
        float rs[4];
#pragma unroll
        for (int t = 0; t < 4; ++t) rs[t] = 1.0f / sqrtf(wave_sum(s[t]) * (1.f / D) + EPS);
#pragma unroll
        for (int j = 0; j < 4; ++j) { const int col = 4 * F.lane + 256 * j;
            const f32x4 g = *(const f32x4*)(F.g_attn_pre + col), sh = *(const f32x4*)(mod + col), sc = *(const f32x4*)(mod + D + col);
#pragma unroll
            for (int t = 0; t < 4; ++t) { unsigned long long* o8 = (unsigned long long*)(F.XN + (size_t)(m0 + t) * D) + F.lane;
                const f32x4 h = (v[t][j] * rs[t] * g) * (sc + 1.f) + sh;
                o8[64 * j] = (unsigned long long)pk2(h.x, h.y) | ((unsigned long long)pk2(h.z, h.w) << 32); } }
    }
}
__device__ __forceinline__ void p4_combine(Frame& F) {
    const int gw = blockIdx.x * NWAVES + F.wave, NGW = F.G * NWAVES;
    constexpr size_t PSTR = (size_t)M * 512;
    const int hd = F.lane >> 3;
    const f32x4 ga0 = *(const f32x4*)(F.g_mix_a + 8 * F.lane), ga1 = *(const f32x4*)(F.g_mix_a + 8 * F.lane + 4), gb0 = *(const f32x4*)(F.g_mix_b + 8 * F.lane), gb1 = *(const f32x4*)(F.g_mix_b + 8 * F.lane + 4);
    for (int m0 = 4 * gw; m0 < M; m0 += 4 * NGW) {
        v4u pa[4], p1[4], p2[4], p3[4]; float l1[4], l2[4], l3[4];
#pragma unroll
        for (int t = 0; t < 4; ++t) { const int m = m0 + t; const size_t off = (size_t)m * 512 + 8 * F.lane;
            pa[t] = __builtin_nontemporal_load((const v4u*)(F.PART + off)); p1[t] = __builtin_nontemporal_load((const v4u*)(F.PART + PSTR + off)); p2[t] = __builtin_nontemporal_load((const v4u*)(F.PART + 2 * PSTR + off)); p3[t] = __builtin_nontemporal_load((const v4u*)(F.PART + 3 * PSTR + off));
            l1[t] = F.LSE[(size_t)hd * M + m]; l2[t] = F.LSE[(size_t)(8 + hd) * M + m]; l3[t] = F.LSE[(size_t)(16 + hd) * M + m]; }
#pragma unroll
        for (int t = 0; t < 4; ++t) { const int m = m0 + t;
            const float mx = fmaxf(l1[t], fmaxf(l2[t], l3[t]));
            float w1 = __expf(l1[t] - mx), w2 = __expf(l2[t] - mx), w3 = __expf(l3[t] - mx); const float inv = 1.f / (w1 + w2 + w3); w1 *= inv; w2 *= inv; w3 *= inv;
            float oa[8], ob[8]; float sa = 0.f, sb = 0.f;
#pragma unroll
            for (int q = 0; q < 4; ++q) {
                oa[2 * q] = bf_lo(pa[t][q]); oa[2 * q + 1] = bf_hi(pa[t][q]);
                ob[2 * q] = w1 * bf_lo(p1[t][q]) + w2 * bf_lo(p2[t][q]) + w3 * bf_lo(p3[t][q]); ob[2 * q + 1] = w1 * bf_hi(p1[t][q]) + w2 * bf_hi(p2[t][q]) + w3 * bf_hi(p3[t][q]);
                sa += oa[2 * q] * oa[2 * q] + oa[2 * q + 1] * oa[2 * q + 1]; sb += ob[2 * q] * ob[2 * q] + ob[2 * q + 1] * ob[2 * q + 1]; }
            const float ra = 1.0f / sqrtf(wave_sum(sa) * (1.f / 512.f) + EPS), rb = 1.0f / sqrtf(wave_sum(sb) * (1.f / 512.f) + EPS);
            v4u wa, wb;
            wa.x = pk2(oa[0] * ra * ga0[0], oa[1] * ra * ga0[1]); wa.y = pk2(oa[2] * ra * ga0[2], oa[3] * ra * ga0[3]); wa.z = pk2(oa[4] * ra * ga1[0], oa[5] * ra * ga1[1]); wa.w = pk2(oa[6] * ra * ga1[2], oa[7] * ra * ga1[3]);
            wb.x = pk2(ob[0] * rb * gb0[0], ob[1] * rb * gb0[1]); wb.y = pk2(ob[2] * rb * gb0[2], ob[3] * rb * gb0[3]); wb.z = pk2(ob[4] * rb * gb1[0], ob[5] * rb * gb1[1]); wb.w = pk2(ob[6] * rb * gb1[2], ob[7] * rb * gb1[3]);
            *(v4u*)(F.MIXED + (size_t)m * D + 8 * F.lane) = wa; *(v4u*)(F.MIXED + (size_t)m * D + 512 + 8 * F.lane) = wb; }
    }
}
__device__ __forceinline__ void p6_mid(Frame& F) {
    const int gw = blockIdx.x * NWAVES + F.wave, NGW = F.G * NWAVES;
    for (int m0 = 2 * gw; m0 < M; m0 += 2 * NGW) {
        const int b = m0 / SEQ; const float* mod = F.MOD + b * NMOD;
        f32x4 v[2][4], xv[2][4]; float s[2] = {0.f, 0.f};
#pragma unroll
        for (int t = 0; t < 2; ++t) { const v2u* yr = (const v2u*)(F.Y1 + (size_t)(m0 + t) * D) + F.lane; const f32x4* xr = (const f32x4*)(F.x + (size_t)(m0 + t) * D) + F.lane;
#pragma unroll
            for (int j = 0; j < 4; ++j) { const v2u w = __builtin_nontemporal_load(yr + 64 * j); v[t][j] = (f32x4){bf_lo(w.x), bf_hi(w.x), bf_lo(w.y), bf_hi(w.y)}; xv[t][j] = __builtin_nontemporal_load(xr + 64 * j); } }
#pragma unroll
        for (int t = 0; t < 2; ++t)
#pragma unroll
            for (int j = 0; j < 4; ++j) s[t] += (v[t][j].x * v[t][j].x + v[t][j].y * v[t][j].y) + (v[t][j].z * v[t][j].z + v[t][j].w * v[t][j].w);
        float rs[2], s2[2] = {0.f, 0.f};
#pragma unroll
        for (int t = 0; t < 2; ++t) { rs[t] = 1.0f / sqrtf(wave_sum(s[t]) * (1.f / D) + EPS); if (F.lane == 0) F.RS1[m0 + t] = rs[t]; }
#pragma unroll
        for (int j = 0; j < 4; ++j) { const int col = 4 * F.lane + 256 * j;
            const f32x4 gg = *(const f32x4*)(F.g_attn_post + col) * *(const f32x4*)(mod + 2 * D + col);
#pragma unroll
            for (int t = 0; t < 2; ++t) {
                xv[t][j] = xv[t][j] + gg * (v[t][j] * rs[t]);
                s2[t] += (xv[t][j].x * xv[t][j].x + xv[t][j].y * xv[t][j].y) + (xv[t][j].z * xv[t][j].z + xv[t][j].w * xv[t][j].w); } }
        float rs2[2];
#pragma unroll
        for (int t = 0; t < 2; ++t) rs2[t] = 1.0f / sqrtf(wave_sum(s2[t]) * (1.f / D) + EPS);
#pragma unroll
        for (int j = 0; j < 4; ++j) { const int col = 4 * F.lane + 256 * j;
            const f32x4 g = *(const f32x4*)(F.g_mlp_pre + col), sh = *(const f32x4*)(mod + 3 * D + col), sc = *(const f32x4*)(mod + 4 * D + col);
#pragma unroll
            for (int t = 0; t < 2; ++t) { unsigned long long* o8 = (unsigned long long*)(F.XN + (size_t)(m0 + t) * D) + F.lane;
                const f32x4 h = (xv[t][j] * rs2[t] * g) * (sc + 1.f) + sh;
                o8[64 * j] = (unsigned long long)pk2(h.x, h.y) | ((unsigned long long)pk2(h.z, h.w) << 32); } }
    }
}
__device__ __forceinline__ void p9_final(Frame& F) {
    const int gw = blockIdx.x * NWAVES + F.wave, NGW = F.G * NWAVES;
    for (int m0 = 2 * gw; m0 < M; m0 += 2 * NGW) {
        const int b = m0 / SEQ; const float* mod = F.MOD + b * NMOD;
        f32x4 v1[2][4], v2[2][4], xv[2][4]; float s[2] = {0.f, 0.f}, rs1[2];
#pragma unroll
        for (int t = 0; t < 2; ++t) { const v2u* y1r = (const v2u*)(F.Y1 + (size_t)(m0 + t) * D) + F.lane; const v2u* y2r = (const v2u*)(F.Y2 + (size_t)(m0 + t) * D) + F.lane; const f32x4* xr = (const f32x4*)(F.x + (size_t)(m0 + t) * D) + F.lane;
            rs1[t] = F.RS1[m0 + t];
#pragma unroll
            for (int j = 0; j < 4; ++j) { const v2u w1 = __builtin_nontemporal_load(y1r + 64 * j), w2 = __builtin_nontemporal_load(y2r + 64 * j); v1[t][j] = (f32x4){bf_lo(w1.x), bf_hi(w1.x), bf_lo(w1.y), bf_hi(w1.y)}; v2[t][j] = (f32x4){bf_lo(w2.x), bf_hi(w2.x), bf_lo(w2.y), bf_hi(w2.y)};
                xv[t][j] = __builtin_nontemporal_load(xr + 64 * j); } }
#pragma unroll
        for (int t = 0; t < 2; ++t)
#pragma unroll
            for (int j = 0; j < 4; ++j) s[t] += (v2[t][j].x * v2[t][j].x + v2[t][j].y * v2[t][j].y) + (v2[t][j].z * v2[t][j].z + v2[t][j].w * v2[t][j].w);
        float rs[2];
#pragma unroll
        for (int t = 0; t < 2; ++t) rs[t] = 1.0f / sqrtf(wave_sum(s[t]) * (1.f / D) + EPS);
#pragma unroll
        for (int j = 0; j < 4; ++j) { const int col = 4 * F.lane + 256 * j;
            const f32x4 gga = *(const f32x4*)(F.g_attn_post + col) * *(const f32x4*)(mod + 2 * D + col), ggm = *(const f32x4*)(F.g_mlp_post + col) * *(const f32x4*)(mod + 5 * D + col);
#pragma unroll
            for (int t = 0; t < 2; ++t) { f32x4* orow = (f32x4*)(F.out + (size_t)(m0 + t) * D) + F.lane;
                const f32x4 x1 = xv[t][j] + gga * (v1[t][j] * rs1[t]);
                __builtin_nontemporal_store(x1 + ggm * (v2[t][j] * rs[t]), orow + 64 * j); } }
    }
}

constexpr int VROW = 144;
constexpr int ATT_WAVE_LDS = 18432;
constexpr float SC2 = 0.125f * 1.4426950408889634f;
typedef short v4i16_t __attribute__((ext_vector_type(4)));
__device__ __forceinline__ s16x4 vtr(const LAS unsigned char* p) { return __builtin_bit_cast(s16x4, __builtin_amdgcn_ds_read_tr16_b64_v4i16((LAS v4i16_t*)p)); }

struct AttnP { int br, d, i0, kt0, qcol, kcol, vcol, maxd, h; size_t rowbase; };
__device__ __forceinline__ AttnP attn_decode(int w, int k, int wv) {
    AttnP p; const int br = k >> 1, j = 2 * w + (k & 1), h = j & 7, tg = (j >> 3) * 8 + wv, b = tg >> 5, tt = tg & 31; p.h = h;
    const int dsh = br < 2 ? 0 : (br == 2 ? 2 : 4);
    const int r = tt >> (5 - dsh), it = tt & ((32 >> dsh) - 1);
    p.br = br; p.d = 1 << dsh; p.i0 = it * 64; p.kt0 = it < 2 ? 4 - 2 * it : 0;
    p.qcol = br == 0 ? h * 64 : 768 + h * 64; p.kcol = br == 0 ? 512 + (h >> 2) * 64 : 1280 + h * 64; p.vcol = br == 0 ? 640 + (h >> 2) * 64 : 1792 + h * 64;
    p.maxd = br == 0 ? 127 : 128; p.rowbase = (size_t)b * SEQ + r;
    return p;
}
__device__ __forceinline__ void attn_loads(const bf16* P, unsigned sk, unsigned sv, unsigned lv, unsigned vstep, v4u (&kr)[4], v4u (&vr)[4]) {
    const char* Pb = (const char*)P;
#pragma unroll
    for (int i = 0; i < 4; ++i) kr[i] = *(const v4u*)(Pb + (size_t)(sk + lv + vstep * i));
#pragma unroll
    for (int i = 0; i < 4; ++i) vr[i] = *(const v4u*)(Pb + (size_t)(sv + lv + vstep * i));
}
__device__ __forceinline__ unsigned attn_tile_base(const AttnP& p, int kt, int col) { return (unsigned)(((unsigned)(col >> 6) * (unsigned)M + (unsigned)p.rowbase + (unsigned)p.d * (unsigned)(p.i0 - 128 + 32 * kt)) * 64u) * 2u; }
constexpr int QROW = 144;
__device__ __forceinline__ void attn_qload(const bf16* P, const AttnP& p, int lane, v4u (&qt)[8]) {
    const char* Pb = (const char*)P;
    const unsigned base = (unsigned)(((unsigned)(p.qcol >> 6) * (unsigned)M + (unsigned)p.rowbase + (unsigned)p.d * (unsigned)(p.i0 + (lane >> 3))) * 64u + (unsigned)(8 * (lane & 7))) * 2u, step = (unsigned)(8 * p.d * 64 * 2);
#pragma unroll
    for (int i = 0; i < 8; ++i) qt[i] = *(const v4u*)(Pb + (size_t)(base + step * i));
}
__device__ __forceinline__ void attn_qstore(LAS unsigned char* ql, int lane, const v4u (&qt)[8]) {
#pragma unroll
    for (int i = 0; i < 8; ++i) *(LAS v4u*)(ql + ((lane >> 3) + 8 * i) * QROW + (lane & 7) * 16) = qt[i];
}

struct AttnSt { float mrun[2], lrun[2]; f32x16 O0[2], O1[2]; };
template <int MASK> __device__ __forceinline__ void attn_half(AttnSt& st, const int a, f32x16 S, const bf16x8 (&va0)[2], const bf16x8 (&va1)[2], int qh  , int farlim  ) {
    if (MASK == 1) {
#pragma unroll
        for (int i = 0; i < 16; ++i) S[i] = (qh <= farlim + (8 * (i >> 2) + (i & 3))) ? S[i] : -1e30f;
    } else if (MASK == 2) {
#pragma unroll
        for (int i = 0; i < 16; ++i) S[i] = (qh >= (8 * (i >> 2) + (i & 3))) ? S[i] : -1e30f;
    }
    float mx = S[0];
#pragma unroll
    for (int i = 1; i < 16; ++i) mx = fmaxf(mx, S[i]);
    mx = fmaxf(mx, __shfl_xor(mx, 32));
    const float mnew = fmaxf(st.mrun[a], mx), alpha = __builtin_amdgcn_exp2f((st.mrun[a] - mnew) * SC2), nb = -mnew * SC2;
    float rsum = 0.f;
#pragma unroll
    for (int i = 0; i < 16; ++i) { S[i] = __builtin_amdgcn_exp2f(__builtin_fmaf(S[i], SC2, nb)); rsum += S[i]; }
    rsum += __shfl_xor(rsum, 32);
    st.lrun[a] = st.lrun[a] * alpha + rsum; st.mrun[a] = mnew;
#pragma unroll
    for (int i = 0; i < 16; ++i) { st.O0[a][i] *= alpha; st.O1[a][i] *= alpha; }
#pragma unroll
    for (int kk = 0; kk < 2; ++kk) {
        v4u pw; pw.x = pk2(S[8 * kk + 0], S[8 * kk + 1]); pw.y = pk2(S[8 * kk + 2], S[8 * kk + 3]); pw.z = pk2(S[8 * kk + 4], S[8 * kk + 5]); pw.w = pk2(S[8 * kk + 6], S[8 * kk + 7]);
        const bf16x8 pb = __builtin_bit_cast(bf16x8, pw);
        st.O0[a] = __builtin_amdgcn_mfma_f32_32x32x16_bf16(va0[kk], pb, st.O0[a], 0, 0, 0);
        st.O1[a] = __builtin_amdgcn_mfma_f32_32x32x16_bf16(va1[kk], pb, st.O1[a], 0, 0, 0); }
}
template <int KT> __device__ __forceinline__ void attn_step(AttnSt& st, const bf16* P, const AttnP& p, const AttnP& pn, unsigned lv, unsigned lvn,
                                                            LAS unsigned char* vl, const LAS unsigned char* qrd, const LAS unsigned char* trb, int lane, v4u (&kn)[4], v4u (&vn)[4]) {
    asm volatile("" ::: "memory");
#pragma unroll
    for (int i = 0; i < 4; ++i) { *(LAS v4u*)(vl + ((lane >> 3) + 8 * i) * VROW + (lane & 7) * 16) = vn[i]; *(LAS v4u*)(vl + 32 * VROW + ((lane >> 3) + 8 * i) * VROW + (lane & 7) * 16) = kn[i]; }
    if (KT < 5) attn_loads(P, attn_tile_base(p, KT + 1, p.kcol), attn_tile_base(p, KT + 1, p.vcol), lv, (unsigned)(8 * p.d * 64 * 2), kn, vn);
    else        attn_loads(P, attn_tile_base(pn, pn.kt0, pn.kcol), attn_tile_base(pn, pn.kt0, pn.vcol), lvn, (unsigned)(8 * pn.d * 64 * 2), kn, vn);
    bf16x8 kf[4];
#pragma unroll
    for (int kd = 0; kd < 4; ++kd) kf[kd] = *(const LAS bf16x8*)(qrd - 32 * VROW + kd * 32);
    constexpr bool act0 = KT <= 4, act1 = KT >= 1;
    f32x16 S0, S1;
#pragma unroll
    for (int i = 0; i < 16; ++i) { S0[i] = 0.f; S1[i] = 0.f; }
#pragma unroll
    for (int kd = 0; kd < 4; ++kd) {
        if (act0) S0 = __builtin_amdgcn_mfma_f32_32x32x16_bf16(kf[kd], *(const LAS bf16x8*)(qrd + kd * 32), S0, 0, 0, 0);
        if (act1) S1 = __builtin_amdgcn_mfma_f32_32x32x16_bf16(kf[kd], *(const LAS bf16x8*)(qrd + 32 * QROW + kd * 32), S1, 0, 0, 0);
    }
    bf16x8 va0[2], va1[2];
#pragma unroll
    for (int kk = 0; kk < 2; ++kk) {
        const s16x4 lo0 = vtr(trb + kk * 16 * VROW), up0 = vtr(trb + kk * 16 * VROW + 8 * VROW), lo1 = vtr(trb + kk * 16 * VROW + 64), up1 = vtr(trb + kk * 16 * VROW + 8 * VROW + 64);
        va0[kk] = (bf16x8){lo0[0], lo0[1], lo0[2], lo0[3], up0[0], up0[1], up0[2], up0[3]}; va1[kk] = (bf16x8){lo1[0], lo1[1], lo1[2], lo1[3], up1[0], up1[1], up1[2], up1[3]}; }
    const int qh = (lane & 31) - 4 * (lane >> 5), farlim = p.maxd - 128;
    if (act0) attn_half<KT == 0 ? 1 : (KT == 4 ? 2 : 0)>(st, 0, S0, va0, va1, qh, farlim);
    if (act1) attn_half<KT == 1 ? 1 : (KT == 5 ? 2 : 0)>(st, 1, S1, va0, va1, qh, farlim);
    asm volatile("" ::: "memory");
}

__device__ __forceinline__ void attn_phase(Frame& F) {
    const int lane = F.lane, wv = F.wave, q = lane & 31, hi = lane >> 5;
    LAS unsigned char* vl = F.lds + wv * ATT_WAVE_LDS;
    LAS unsigned char* ql = vl + 64 * VROW;
    const LAS unsigned char* qrd = ql + q * QROW + hi * 16;
    const LAS unsigned char* trb = vl + (4 * hi + ((lane & 15) >> 2)) * VROW + (16 * ((lane >> 4) & 1) + 4 * (lane & 3)) * 2;
    const bf16* P = F.PROJ;
    const int bx = blockIdx.x, w = (bx & 7) * 32 + (bx >> 3);
    if (F.G != 256) return;
    AttnP p = attn_decode(w, 0, wv), pn = attn_decode(w, 1, wv);
    v4u kn[4], vn[4];
    { v4u qt[8]; attn_qload(P, p, lane, qt); attn_qstore(ql, lane, qt); }
    unsigned lv = (unsigned)(((lane >> 3) * p.d) * 64 + 8 * (lane & 7)) * 2u, lvn = (unsigned)(((lane >> 3) * pn.d) * 64 + 8 * (lane & 7)) * 2u;
    attn_loads(P, attn_tile_base(p, p.kt0, p.kcol), attn_tile_base(p, p.kt0, p.vcol), lv, (unsigned)(8 * p.d * 64 * 2), kn, vn);
#pragma unroll 1
    for (int k = 0; k < 8; ++k) {
        AttnSt st;
#pragma unroll
        for (int a = 0; a < 2; ++a) { st.mrun[a] = p.br == 0 ? F.sink_a[p.h] * 8.0f : -5e29f; st.lrun[a] = p.br == 0 ? 1.f : 0.f;
#pragma unroll
            for (int i = 0; i < 16; ++i) { st.O0[a][i] = 0.f; st.O1[a][i] = 0.f; } }
        if (p.kt0 <= 0) attn_step<0>(st, P, p, pn, lv, lvn, vl, qrd, trb, lane, kn, vn);
        if (p.kt0 <= 1) attn_step<1>(st, P, p, pn, lv, lvn, vl, qrd, trb, lane, kn, vn);
        if (p.kt0 <= 2) attn_step<2>(st, P, p, pn, lv, lvn, vl, qrd, trb, lane, kn, vn);
        if (p.kt0 <= 3) attn_step<3>(st, P, p, pn, lv, lvn, vl, qrd, trb, lane, kn, vn);
        attn_step<4>(st, P, p, pn, lv, lvn, vl, qrd, trb, lane, kn, vn);
        v4u qt[8];
        if (k < 7) attn_qload(P, pn, lane, qt);
        attn_step<5>(st, P, p, pn, lv, lvn, vl, qrd, trb, lane, kn, vn);
        if (k < 7) { asm volatile("" ::: "memory"); attn_qstore(ql, lane, qt); }
#pragma unroll
        for (int a = 0; a < 2; ++a) {
            const float invl = 1.f / st.lrun[a];
            asm volatile("" ::: "memory");
#pragma unroll
            for (int g = 0; g < 4; ++g) {
                v2u w0, w1; w0.x = pk2(st.O0[a][4 * g] * invl, st.O0[a][4 * g + 1] * invl); w0.y = pk2(st.O0[a][4 * g + 2] * invl, st.O0[a][4 * g + 3] * invl);
                w1.x = pk2(st.O1[a][4 * g] * invl, st.O1[a][4 * g + 1] * invl); w1.y = pk2(st.O1[a][4 * g + 2] * invl, st.O1[a][4 * g + 3] * invl);
                *(LAS v2u*)(vl + q * VROW + (8 * g + 4 * hi) * 2) = w0; *(LAS v2u*)(vl + q * VROW + (32 + 8 * g + 4 * hi) * 2) = w1; }
            asm volatile("s_waitcnt lgkmcnt(0)" ::: "memory");
            v4u orw[4];
#pragma unroll
            for (int i = 0; i < 4; ++i) orw[i] = *(const LAS v4u*)(vl + ((lane >> 3) + 8 * i) * VROW + (lane & 7) * 16);
            asm volatile("s_waitcnt lgkmcnt(0)" : "+v"(orw[0]), "+v"(orw[1]), "+v"(orw[2]), "+v"(orw[3]) :: "memory");
            bf16* ob = F.PART + (size_t)p.br * M * 512 + p.h * 64 + 8 * (lane & 7);
#pragma unroll
            for (int i = 0; i < 4; ++i) *(v4u*)(ob + (p.rowbase + (size_t)p.d * (p.i0 + 32 * a + (lane >> 3) + 8 * i)) * 512) = orw[i];
#pragma unroll
            for (int i = 0; i < 4; ++i) asm volatile("v_mov_b32 %0, %0\n\tv_mov_b32 %1, %1\n\tv_mov_b32 %2, %2\n\tv_mov_b32 %3, %3" : "+v"(orw[i].x), "+v"(orw[i].y), "+v"(orw[i].z), "+v"(orw[i].w) :: "memory");
            if (p.br > 0 && hi == 0) F.LSE[((size_t)(p.br - 1) * 8 + p.h) * M + p.rowbase + (size_t)p.d * (p.i0 + 32 * a + q)] = st.mrun[a] * 0.125f + __logf(st.lrun[a]);
        }
        if (k == 7) break;
        p = pn; pn = attn_decode(w, k + 2 < 8 ? k + 2 : 7, wv);
        lv = lvn; lvn = (unsigned)(((lane >> 3) * pn.d) * 64 + 8 * (lane & 7)) * 2u;
    }
}

#define XB_TMO      128
#define XB_XCNT(j)  (256  + 64 * (j))
#define XB_XSUB(j)  (1280 + 64 * (j))
#define XB_XGEN(j)  (2304 + 64 * (j))
#define XB_TOP      3328
#define XB_TOPGEN   3392
#define XCD_BAR_WORDS 3456
#define XB_SPIN_CAP (1u << 18)

__device__ __forceinline__ unsigned xb_ld(unsigned* p)              { return __hip_atomic_load(p, __ATOMIC_RELAXED, __HIP_MEMORY_SCOPE_AGENT); }
__device__ __forceinline__ unsigned xb_add(unsigned* p, unsigned v) { return __hip_atomic_fetch_add(p, v, __ATOMIC_RELAXED, __HIP_MEMORY_SCOPE_AGENT); }
__device__ __forceinline__ unsigned xb_xcc_id() { return (unsigned)__builtin_amdgcn_s_getreg((3 << 11) | 20) & 0xFu; }
#define XB_SPIN(cond, bar) do { unsigned _sp = 0; while (cond) { __builtin_amdgcn_s_sleep(1); \
    if ((++_sp & 255u) == 0u) { if (xb_ld(&(bar)[XB_TMO])) break; if (_sp > XB_SPIN_CAP) { atomicAdd(&(bar)[XB_TMO], 1u); break; } } } } while (0)

struct XcdBarrier {
    unsigned* bar; unsigned x;
    volatile LAS unsigned* st;
};

__device__ __forceinline__ XcdBarrier xcd_barrier_post(unsigned* bar, volatile LAS unsigned* st) {
    XcdBarrier b; b.bar = bar; b.x = xb_xcc_id(); b.st = st;
    if (threadIdx.x == 0) (void)xb_add(&bar[XB_XCNT(b.x)], 1u);
    return b;
}
__device__ __forceinline__ void xcd_barrier_complete(unsigned* bar, unsigned x, unsigned& nloc, unsigned& nx) {
    const unsigned G = gridDim.x * gridDim.y * gridDim.z;
    unsigned sum, cnt, mine, sp = 0u;
    for (;;) {
        sum = 0u; cnt = 0u; mine = 0u;
#pragma unroll
        for (unsigned j = 0; j < 16; ++j) { const unsigned c = xb_ld(&bar[XB_XCNT(j)]); sum += c; cnt += (c > 0u) ? 1u : 0u; mine = (j == x) ? c : mine; }
        if (sum == G) break;
        __builtin_amdgcn_s_sleep(1);
        if ((++sp & 255u) == 0u) { if (xb_ld(&bar[XB_TMO])) break; if (sp > XB_SPIN_CAP) { atomicAdd(&bar[XB_TMO], 1u); break; } }
    }
    nloc = mine > 0u ? mine : 1u; nx = cnt > 0u ? cnt : 1u;
}

__device__ __forceinline__ void xcd_barrier(const XcdBarrier& b) {
    asm volatile("s_waitcnt vmcnt(0)" ::: "memory");
    __syncthreads();
    if (threadIdx.x == 0) {
        unsigned* bar = b.bar;
        __builtin_amdgcn_s_waitcnt(0);
        unsigned nloc = b.st[0], nx = b.st[1];
        if (nloc == 0u) { xcd_barrier_complete(bar, b.x, nloc, nx); b.st[0] = nloc; b.st[1] = nx; }
        const unsigned old = xb_add(&bar[XB_XSUB(b.x)], 1u);
        const unsigned gen = old / nloc;
        if (old + 1u == (gen + 1u) * nloc) {
            __builtin_amdgcn_fence(__ATOMIC_RELEASE, "agent");
            asm volatile("s_waitcnt vmcnt(0)" ::: "memory");
            const unsigned og = xb_add(&bar[XB_TOP], 1u);
            const unsigned tg = og / nx;
            if (og + 1u == (tg + 1u) * nx) xb_add(&bar[XB_TOPGEN], 1u);
            else XB_SPIN(xb_ld(&bar[XB_TOPGEN]) == tg, bar);
            __builtin_amdgcn_fence(__ATOMIC_ACQUIRE, "agent");
            xb_add(&bar[XB_XGEN(b.x)], 1u);
            asm volatile("s_waitcnt vmcnt(0)" ::: "memory");
        } else {
            XB_SPIN(xb_ld(&bar[XB_XGEN(b.x)]) == gen, bar);
            __builtin_amdgcn_fence(__ATOMIC_ACQUIRE, "agent");
            asm volatile("s_waitcnt vmcnt(0)" ::: "memory");
        }
    }
    __syncthreads();
}

struct Args { const void* in[16]; float* out; unsigned char* ws; int ph_lo, ph_hi; };
__global__ void __launch_bounds__(NWAVES * 64, 2) fwd_kernel(Args args) {
    extern __shared__ __attribute__((aligned(16))) unsigned char lds[];
    cooperative_groups::grid_group grid = cooperative_groups::this_grid();
    Frame F;
    F.lds = (LAS unsigned char*)lds;
    F.tid = threadIdx.x; F.lane = F.tid & 63; F.wave = __builtin_amdgcn_readfirstlane(F.tid >> 6); F.G = gridDim.x;
    unsigned char* ws = args.ws;
    F.x = (const float*)args.in[0]; F.c = (const float*)args.in[1]; F.positions = (const int*)args.in[2]; F.w_ada = (const float*)args.in[3]; F.b_ada = (const float*)args.in[4];
    F.g_attn_pre = (const float*)args.in[5]; F.g_attn_post = (const float*)args.in[6]; F.w_in = (const float*)args.in[7]; F.sink_a = (const float*)args.in[8];
    F.g_mix_a = (const float*)args.in[9]; F.g_mix_b = (const float*)args.in[10]; F.w_out = (const float*)args.in[11]; F.g_mlp_pre = (const float*)args.in[12]; F.g_mlp_post = (const float*)args.in[13];
    F.w_up = (const float*)args.in[14]; F.w_down = (const float*)args.in[15]; F.out = args.out;
    F.Win_t = (bf16*)(ws + WS_WIN); F.Wout_t = (bf16*)(ws + WS_WOUT); F.Wup_t = (bf16*)(ws + WS_WUP); F.Wdn_t = (bf16*)(ws + WS_WDN);
    F.MOD = (float*)(ws + WS_MOD); F.ROPE = (float*)(ws + WS_ROPE); F.LSE = (float*)(ws + WS_LSE); F.RS1 = (float*)(ws + WS_LSE);
    F.XN = (bf16*)(ws + WS_XN); F.PROJ = (bf16*)(ws + WS_PROJ); F.MIXED = (bf16*)(ws + WS_MIXED); F.PART = (bf16*)(ws + WS_PART); F.HB = (bf16*)(ws + WS_H); F.Y1 = (bf16*)(ws + WS_Y); F.X1 = (float*)(ws + WS_X1); F.Y2 = (bf16*)(ws + WS_Y2);
    const int lo = args.ph_lo, hi = args.ph_hi;
    unsigned* barw = (unsigned*)(ws + WS_CTL);
    volatile LAS unsigned* bst = (volatile LAS unsigned*)(F.lds + 8 * 18432 + 64);
    if (F.tid < 2) bst[F.tid] = 0u;
    if (hi - lo > 1 && blockIdx.x == 0) for (int i = F.tid; i < XCD_BAR_WORDS; i += NWAVES * 64) __hip_atomic_store(barw + i, 0u, __ATOMIC_RELAXED, __HIP_MEMORY_SCOPE_AGENT);
    __syncthreads();
    XcdBarrier bar; bar.bar = barw; bar.x = 0; bar.st = bst;
    if (hi - lo > 1) { grid.sync(); bar = xcd_barrier_post(barw, bst); }
#define IN(k) (lo <= (k) && (k) < hi)
#define SEAM0() SEAM(0)
#define SEAM(k) do { if (IN(k) && IN((k) + 1)) xcd_barrier(bar); } while (0)

    if (IN(0)) { p0_prologue(F); } SEAM0();
    if (IN(1)) { p1_prenorm(F); } SEAM(1);
    if (IN(2)) {
        pg8::Gemm g{F.XN, F.Win_t, M, INW, D}; pg8::StaticOrder S; S.init(M, INW, F.G, (int)blockIdx.x);
        pg8::EpiProj E{F.PROJ, INW, F.ROPE};
        pg8::gemm_phase<pg8::EpiProj, pg8::StaticOrder, PG8_ALIGN, PG8_SP2>(F.lds, g, S, E);
    } SEAM(2);
    if (IN(3)) { attn_phase(F); } SEAM(3);
    if (IN(4)) { p4_combine(F); } SEAM(4);
    if (IN(5)) {
        pg8::Gemm g{F.MIXED, F.Wout_t, M, D, D}; pg8::StaticOrder S; S.init(M, D, F.G, (int)blockIdx.x);
        pg8::EpiBf E{F.Y1, D};
        pg8::gemm_phase<pg8::EpiBf, pg8::StaticOrder, PG8_ALIGN, PG8_SP2>(F.lds, g, S, E);
    } SEAM(5);
    if (IN(6)) { p6_mid(F); } SEAM(6);
    if (IN(7)) {
        pg8::Gemm g{F.XN, F.Wup_t, M, FF, D}; pg8::StaticOrder S; S.init(M, FF, F.G, (int)blockIdx.x);
        pg8::EpiSqRelu E{F.HB, FF};
        pg8::gemm_phase<pg8::EpiSqRelu, pg8::StaticOrder, PG8_ALIGN, PG8_SP2>(F.lds, g, S, E);
    } SEAM(7);
    if (IN(8)) {
        pg8::Gemm g{F.HB, F.Wdn_t, M, D, FF}; pg8::StaticOrder S; S.init(M, D, F.G, (int)blockIdx.x);
        pg8::EpiBf E{F.Y2, D};
        pg8::gemm_phase<pg8::EpiBf, pg8::StaticOrder, PG8_ALIGN, PG8_SP2>(F.lds, g, S, E);
    } SEAM(8);
    if (IN(9)) { p9_final(F); }
#undef IN
#undef SEAM
#undef SEAM0
}

extern "C" void kernel_launch(void* const* d_in, const int* in_sizes, int n_in, void* d_out, int out_size, void* d_ws, size_t ws_size, hipStream_t stream) {
    static int grid = 0;
    if (grid == 0) {
        if (n_in != 16 || in_sizes[0] != M * D || out_size != M * D || ws_size < WS_END) { fprintf(stderr, "kernel_launch: unexpected shapes (n_in %d, in0 %d, out %d, ws %zu); nothing launched\n", n_in, n_in > 0 ? in_sizes[0] : -1, out_size, ws_size); grid = -1; return; }
        int dev = 0, cus = 0, per_cu = 0;
        if (hipGetDevice(&dev) != hipSuccess || hipDeviceGetAttribute(&cus, hipDeviceAttributeMultiprocessorCount, dev) != hipSuccess) { grid = -1; return; }
        if (hipFuncSetAttribute((const void*)fwd_kernel, hipFuncAttributeMaxDynamicSharedMemorySize, LDS_BYTES) != hipSuccess) { fprintf(stderr, "kernel_launch: hipFuncSetAttribute failed\n"); grid = -1; return; }
        if (hipOccupancyMaxActiveBlocksPerMultiprocessor(&per_cu, (const void*)fwd_kernel, NWAVES * 64, LDS_BYTES) != hipSuccess || per_cu < 1) { fprintf(stderr, "kernel_launch: occupancy query says %d\n", per_cu); per_cu = 1; }
        (void)hipGetLastError();
        grid = cus * per_cu;
    }
    if (grid < 0) return;
    Args a{};
    for (int i = 0; i < 16; ++i) a.in[i] = d_in[i];
    a.out = (float*)d_out; a.ws = (unsigned char*)d_ws;
#if MK_COOP
    a.ph_lo = 0; a.ph_hi = NPH;
    void* kargs[] = {&a};
    hipError_t e = hipLaunchCooperativeKernel((const void*)fwd_kernel, dim3(grid), dim3(NWAVES * 64), kargs, LDS_BYTES, stream);
    if (e != hipSuccess) fprintf(stderr, "kernel_launch: cooperative launch failed: %s (grid %d)\n", hipGetErrorString(e), grid);
#else
    for (int ph = 0; ph < NPH; ++ph) { a.ph_lo = ph; a.ph_hi = ph + 1; const int reps = (ph == MK_DUP) ? 2 : 1;
        for (int rp = 0; rp < reps; ++rp) hipLaunchKernelGGL(fwd_kernel, dim3(grid), dim3(NWAVES * 64), LDS_BYTES, stream, a); }
#endif
}
```

```cpp
#include <hip/hip_cooperative_groups.h>
#include <hip/hip_runtime.h>
#include <cstdio>
#include <cstdint>
namespace pg8 {
#define PG8_LAS __attribute__((address_space(3)))
typedef unsigned short bf16_t;
typedef short bf16x8 __attribute__((ext_vector_type(8)));
typedef float f32x4 __attribute__((ext_vector_type(4)));
typedef unsigned u32x4 __attribute__((ext_vector_type(4)));
constexpr int BM = 256, BK = 64, HALF = 128, HTB = HALF * BK * 2  , STAGE_BYTES = 8 * HTB, NXCD = 8, WGM = 8;

__host__ __device__ __forceinline__ int lds_byte(int r, int c) { const int st = (r >> 4) * 2 + (c >> 5), rr = r & 15, cc = c & 31, ob = rr * 64 + cc * 2; return st * 1024 + (ob ^ (((ob >> 9) & 1) << 5)); }
__host__ __device__ __forceinline__ void stage_rc(int b, int& R, int& C) { const int st = b / 1024, sb = b % 1024, swz = sb ^ (((sb >> 9) & 1) << 5); R = (st >> 1) * 16 + swz / 64; C = (st & 1) * 32 + (swz % 64) / 2; }
__host__ __device__ __forceinline__ int perm32(int rho) { const int n = rho >> 4, i = rho & 15; return 8 * (i >> 2) + 4 * n + (i & 3); }

struct Unit { int pm, pn; };
struct Gemm { const bf16_t* A; const bf16_t* Bt; int M, N, K; };

struct StaticOrder {
    int nM, nN, nwg, G, c;
    __host__ __device__ void init(int M, int N, int G_, int c_) { nM = M / BM; nN = N / BM; nwg = nM * nN; G = G_; c = c_; }
    __host__ __device__ bool next(int i, Unit& u) const {
        const long L = (long)i * G + c; if (L >= nwg) return false;
        int wgid = (int)L; { const int q = nwg / NXCD, r = nwg % NXCD, xcd = wgid % NXCD, off = wgid / NXCD; wgid = (xcd < r ? xcd * (q + 1) : r * (q + 1) + (xcd - r) * q) + off; }
        const int nig = WGM * nN, gid = wgid / nig, fm = gid * WGM, gsz = (nM - fm) < WGM ? (nM - fm) : WGM;
        u.pm = fm + ((wgid % nig) % gsz); u.pn = (wgid % nig) / gsz; return true;
    }
    __device__ __forceinline__ void a_ready(const Unit&) const {}
    __device__ __forceinline__ void done(const Unit&) const {}
};

__device__ __forceinline__ unsigned cvt_pk_bf16(float lo, float hi) { unsigned r; asm volatile("v_cvt_pk_bf16_f32 %0, %1, %2" : "=v"(r) : "v"(lo), "v"(hi)); return r; }
typedef float f32x2 __attribute__((ext_vector_type(2)));
__device__ __forceinline__ f32x2 gelu_pk(f32x2 v) {
    const f32x2 av = __builtin_elementwise_abs(v), d = av * 0.2316418882f + 1.0f;
    f32x2 t; t.x = __builtin_amdgcn_rcpf(d.x); t.y = __builtin_amdgcn_rcpf(d.y);
    f32x2 q = t * 0.5307027145f + (-0.7265760135f); q = q * t + 0.7107068705f; q = q * t + (-0.142248368f); q = q * t + 0.127414796f; q = q * t;
    const f32x2 s = (v * v) * (-0.72134752044f);
    f32x2 e; e.x = __builtin_amdgcn_exp2f(s.x); e.y = __builtin_amdgcn_exp2f(s.y);
    const f32x2 m = v * (q * e), r = v - m;
    f32x2 o; o.x = v.x < 0.f ? m.x : r.x; o.y = v.y < 0.f ? m.y : r.y; return o;
}

template <int ACT  > struct EpiBf16 {
    static constexpr bool PERM = true, AFTER_DRAIN = false; static_assert(ACT == 0 || ACT == 1, "EpiBf16: ACT is 0 (none) or 1 (gelu_pk)");
    bf16_t* O; int ldc; const float* bias; int split_cols; size_t split_stride; float scale0;
    __device__ __forceinline__ void operator()(const f32x4 (&acc)[2][2][4][2], const Unit& u, int wr, int wc, int fr, int fq) const {
        const int row0 = u.pm * BM + wr * 64 + fr; int colt = u.pn * BM; bf16_t* base = O;
        float sc = 1.f; if (split_cols) { const int t = colt / split_cols; base += (size_t)t * split_stride; colt -= t * split_cols; if (t == 0) sc = scale0; }
        const int col0 = colt + wc * 32 + 8 * fq, bcol0 = u.pn * BM + wc * 32 + 8 * fq;
        f32x4 bv[2][2];
#pragma unroll
        for (int bj = 0; bj < 2; ++bj)
#pragma unroll
            for (int n = 0; n < 2; ++n) bv[bj][n] = bias ? *(const f32x4*)(bias + bcol0 + bj * HALF + 4 * n) : (f32x4){0.f, 0.f, 0.f, 0.f};
#pragma unroll
        for (int ai = 0; ai < 2; ++ai)
#pragma unroll
            for (int m = 0; m < 4; ++m) { bf16_t* rowp = base + (size_t)(row0 + ai * HALF + m * 16) * ldc + col0;
#pragma unroll
                for (int bj = 0; bj < 2; ++bj) { f32x4 v0 = acc[ai][bj][m][0] + bv[bj][0], v1 = acc[ai][bj][m][1] + bv[bj][1];
                    if (ACT == 1) { f32x2 a = gelu_pk((f32x2){v0[0], v0[1]}), b = gelu_pk((f32x2){v0[2], v0[3]}), c = gelu_pk((f32x2){v1[0], v1[1]}), d = gelu_pk((f32x2){v1[2], v1[3]});
                        v0 = (f32x4){a.x, a.y, b.x, b.y}; v1 = (f32x4){c.x, c.y, d.x, d.y}; }
                    v0 = v0 * sc; v1 = v1 * sc; u32x4 w; w.x = cvt_pk_bf16(v0[0], v0[1]); w.y = cvt_pk_bf16(v0[2], v0[3]); w.z = cvt_pk_bf16(v1[0], v1[1]); w.w = cvt_pk_bf16(v1[2], v1[3]);
                    *(u32x4*)(rowp + bj * HALF) = w; } }
    }
};

struct EpiProj {
    static constexpr bool PERM = true, AFTER_DRAIN = false;
    bf16_t* O; int ldc; const float* rope;
    __device__ __forceinline__ void operator()(const f32x4 (&acc)[2][2][4][2], const Unit& u, int wr, int wc, int fr, int fq) const {
        const int row0 = u.pm * BM + wr * 64 + fr; const int colt = u.pn * BM; const int col0 = colt + wc * 32 + 8 * fq;
        const bool wrot = (wc & 1) == 0;
        const float sgn = (fq == 0) ? -1.f : 1.f;
#pragma unroll
        for (int ai = 0; ai < 2; ++ai)
#pragma unroll
            for (int m = 0; m < 4; ++m) {
                const int row = row0 + ai * HALF + m * 16;
                bf16_t* rowp = O + ((size_t)(col0 >> 6) * 32768 + row) * 64 + (col0 & 63);
                f32x4 c0v = {1.f, 1.f, 1.f, 1.f}, c1v = c0v, s0v = {0.f, 0.f, 0.f, 0.f}, s1v = s0v;
                if (wrot) { const f32x4* rp = (const f32x4*)(rope + (size_t)row * 16); c0v = rp[0]; c1v = rp[1]; s0v = rp[2] * sgn; s1v = rp[3] * sgn; }
#pragma unroll
                for (int bj = 0; bj < 2; ++bj) {
                    f32x4 v0 = acc[ai][bj][m][0], v1 = acc[ai][bj][m][1];
                    const int cb = colt + bj * HALF;
                    const bool rot = wrot && (cb < 640 || (cb >= 768 && cb < 1792));
                    if (rot) {
                        f32x4 p0, p1;
#pragma unroll
                        for (int j = 0; j < 4; ++j) { p0[j] = __shfl_xor(v0[j], 16); p1[j] = __shfl_xor(v1[j], 16); }
                        if (fq < 2) { v0 = v0 * c0v + p0 * s0v; v1 = v1 * c1v + p1 * s1v; }
                    }
                    u32x4 w; w.x = cvt_pk_bf16(v0[0], v0[1]); w.y = cvt_pk_bf16(v0[2], v0[3]); w.z = cvt_pk_bf16(v1[0], v1[1]); w.w = cvt_pk_bf16(v1[2], v1[3]);
                    *(u32x4*)(rowp + (size_t)bj * 2 * 32768 * 64) = w;
                }
            }
    }
};
struct EpiSqRelu {
    static constexpr bool PERM = true, AFTER_DRAIN = false;
    bf16_t* O; int ldc;
    __device__ __forceinline__ void operator()(const f32x4 (&acc)[2][2][4][2], const Unit& u, int wr, int wc, int fr, int fq) const {
        const int row0 = u.pm * BM + wr * 64 + fr; const int col0 = u.pn * BM + wc * 32 + 8 * fq;
#pragma unroll
        for (int ai = 0; ai < 2; ++ai)
#pragma unroll
            for (int m = 0; m < 4; ++m) { bf16_t* rowp = O + (size_t)(row0 + ai * HALF + m * 16) * ldc + col0;
#pragma unroll
                for (int bj = 0; bj < 2; ++bj) { f32x4 v0 = acc[ai][bj][m][0], v1 = acc[ai][bj][m][1];
                    v0 = __builtin_elementwise_max(v0, (f32x4){0.f, 0.f, 0.f, 0.f}); v1 = __builtin_elementwise_max(v1, (f32x4){0.f, 0.f, 0.f, 0.f}); v0 = v0 * v0; v1 = v1 * v1;
                    u32x4 w; w.x = cvt_pk_bf16(v0[0], v0[1]); w.y = cvt_pk_bf16(v0[2], v0[3]); w.z = cvt_pk_bf16(v1[0], v1[1]); w.w = cvt_pk_bf16(v1[2], v1[3]);
                    *(u32x4*)(rowp + bj * HALF) = w; } }
    }
};
struct EpiBf {
    static constexpr bool PERM = true, AFTER_DRAIN = false;
    bf16_t* O; int ldc;
    __device__ __forceinline__ void operator()(const f32x4 (&acc)[2][2][4][2], const Unit& u, int wr, int wc, int fr, int fq) const {
        const int row0 = u.pm * BM + wr * 64 + fr; const int col0 = u.pn * BM + wc * 32 + 8 * fq;
#pragma unroll
        for (int ai = 0; ai < 2; ++ai)
#pragma unroll
            for (int m = 0; m < 4; ++m) { bf16_t* rowp = O + (size_t)(row0 + ai * HALF + m * 16) * ldc + col0;
#pragma unroll
                for (int bj = 0; bj < 2; ++bj) { const f32x4 v0 = acc[ai][bj][m][0], v1 = acc[ai][bj][m][1];
                    u32x4 w; w.x = cvt_pk_bf16(v0[0], v0[1]); w.y = cvt_pk_bf16(v0[2], v0[3]); w.z = cvt_pk_bf16(v1[0], v1[1]); w.w = cvt_pk_bf16(v1[2], v1[3]);
                    *(u32x4*)(rowp + bj * HALF) = w; } }
    }
};
struct EpiF32 {
    static constexpr bool PERM = true, AFTER_DRAIN = false;
    float* O; int ldc;
    __device__ __forceinline__ void operator()(const f32x4 (&acc)[2][2][4][2], const Unit& u, int wr, int wc, int fr, int fq) const {
        const int row0 = u.pm * BM + wr * 64 + fr; const int col0 = u.pn * BM + wc * 32 + 8 * fq;
#pragma unroll
        for (int ai = 0; ai < 2; ++ai)
#pragma unroll
            for (int m = 0; m < 4; ++m) { float* rowp = O + (size_t)(row0 + ai * HALF + m * 16) * ldc + col0;
#pragma unroll
                for (int bj = 0; bj < 2; ++bj) { *(f32x4*)(rowp + bj * HALF) = acc[ai][bj][m][0]; *(f32x4*)(rowp + bj * HALF + 4) = acc[ai][bj][m][1]; } }
    }
};
template <class Epi, class Sched, bool ALIGN_EPI = false, bool SP2 = false>
__device__ __forceinline__ void gemm_phase(PG8_LAS unsigned char* lds, const Gemm g, const Sched& S, const Epi& E) {
    const int tid = threadIdx.x, wid = __builtin_amdgcn_readfirstlane(tid >> 6), lane = tid & 63, wr = wid >> 2, wc = wid & 3, fr = lane & 15, fq = lane >> 4;
    const int K = g.K, nt = K / BK;
    unsigned voffA[2], voffB[2];
#pragma unroll
    for (int i = 0; i < 2; ++i) { int R, C; stage_rc(tid * 16 + i * 8192, R, C); const int Rb = Epi::PERM ? ((R & ~31) + perm32(R & 31)) : R;
        voffA[i] = (unsigned)(R * K + C) * 2u; voffB[i] = (unsigned)(Rb * K + C) * 2u; }
    const size_t kstep = (size_t)(BK * 2);
    const size_t hstep = (size_t)HALF * K * 2;
    const size_t tstep = 2 * hstep;
    const unsigned ldsw = (unsigned)wid * 1024u;
    const int aoff = lds_byte(wr * 64 + fr, fq * 8), boff = lds_byte(wc * 32 + fr, fq * 8);
#define PG8_SA(b, h) (((b) * 2 + (h)) * HTB)
#define PG8_SB(b, h) ((4 + (b) * 2 + (h)) * HTB)
#define PG8_STAGE(bufoff, gbase, voff) do { _Pragma("unroll") for (int _i = 0; _i < 2; ++_i) \
        __builtin_amdgcn_global_load_lds((const unsigned*)((const char*)(gbase) + (voff)[_i]), (PG8_LAS unsigned*)(lds + (bufoff) + ldsw + _i * 8192), 16, 0, 0); } while (0)
#define PG8_LDA(dst, b, h) do { _Pragma("unroll") for (int m = 0; m < 4; ++m) _Pragma("unroll") for (int k = 0; k < 2; ++k) dst[m][k] = *(const PG8_LAS bf16x8*)(lds + PG8_SA(b, h) + aoff + m * 2048 + k * 1024); } while (0)
#define PG8_LDB(dst, b, h) do { _Pragma("unroll") for (int n = 0; n < 2; ++n) _Pragma("unroll") for (int k = 0; k < 2; ++k) dst[n][k] = *(const PG8_LAS bf16x8*)(lds + PG8_SB(b, h) + boff + n * 2048 + k * 1024); } while (0)
#define PG8_MMA(ai, bj, At, Bt) do { __builtin_amdgcn_s_setprio(1); _Pragma("unroll") for (int m = 0; m < 4; ++m) _Pragma("unroll") for (int n = 0; n < 2; ++n) _Pragma("unroll") for (int k = 0; k < 2; ++k) \
        acc[ai][bj][m][n] = __builtin_amdgcn_mfma_f32_16x16x32_bf16(Bt[n][k], At[m][k], acc[ai][bj][m][n], 0, 0, 0); __builtin_amdgcn_s_setprio(0); } while (0)
#define PG8_WAIT_V(n) asm volatile("s_waitcnt vmcnt(" #n ")" ::: "memory")
#define PG8_WAIT_L(n) asm volatile("s_waitcnt lgkmcnt(" #n ")" ::: "memory")
#define PG8_BAR __builtin_amdgcn_s_barrier()
#define PG8_SCHED __builtin_amdgcn_sched_barrier(0)
    Unit cur, nxt; int ui = 0;
    if (!S.next(0, cur)) return;
    f32x4 acc[2][2][4][2];
#pragma unroll
    for (int a = 0; a < 2; ++a)
#pragma unroll
        for (int b = 0; b < 2; ++b)
#pragma unroll
            for (int m = 0; m < 4; ++m)
#pragma unroll
                for (int n = 0; n < 2; ++n) acc[a][b][m][n] = (f32x4){0.f, 0.f, 0.f, 0.f};
    bf16x8 At[4][2], B0[2][2], B1[2][2];
    const char* cA = (const char*)g.A + (size_t)cur.pm * tstep; const char* cB = (const char*)g.Bt + (size_t)cur.pn * tstep;
    S.a_ready(cur);
    if constexpr (SP2) {
        PG8_STAGE(PG8_SB(0, 0), cB, voffB); PG8_STAGE(PG8_SB(0, 1), cB + hstep, voffB); PG8_STAGE(PG8_SA(0, 0), cA, voffA); PG8_STAGE(PG8_SA(0, 1), cA + hstep, voffA);
        if (wr == 1) PG8_BAR;
        PG8_WAIT_V(2); PG8_BAR;
        PG8_STAGE(PG8_SB(1, 0), cB + kstep, voffB); PG8_STAGE(PG8_SA(1, 0), cA + kstep, voffA); PG8_STAGE(PG8_SB(1, 1), cB + hstep + kstep, voffB);
        PG8_WAIT_V(6); PG8_BAR;
    } else {
        PG8_STAGE(PG8_SB(0, 0), cB, voffB); PG8_STAGE(PG8_SA(0, 0), cA, voffA); PG8_STAGE(PG8_SB(0, 1), cB + hstep, voffB); PG8_STAGE(PG8_SA(0, 1), cA + hstep, voffA);
        if (wr == 1) PG8_BAR;
        PG8_WAIT_V(4); PG8_BAR;
        PG8_STAGE(PG8_SB(1, 0), cB + kstep, voffB); PG8_STAGE(PG8_SA(1, 0), cA + kstep, voffA); PG8_STAGE(PG8_SB(1, 1), cB + hstep + kstep, voffB);
        PG8_WAIT_V(6); PG8_BAR;
    }
    for (;;) {
        const bool has_next = S.next(ui + 1, nxt);
        const char* nA = has_next ? (const char*)g.A + (size_t)nxt.pm * tstep : cA; const char* nB = has_next ? (const char*)g.Bt + (size_t)nxt.pn * tstep : cB;
        for (int t = 0; t < nt; t += 2) {
            const bool last = (t == nt - 2);
            const char* a1 = cA + (size_t)(t + 1) * kstep;
            const char* a2 = last ? nA : cA + (size_t)(t + 2) * kstep; const char* b2 = last ? nB : cB + (size_t)(t + 2) * kstep;
            const char* a3 = a2 + kstep; const char* b3 = b2 + kstep;
            if (last && has_next) S.a_ready(nxt);
            if constexpr (SP2) {
            PG8_LDB(B0, 0, 0); PG8_LDB(B1, 0, 1); PG8_SCHED; PG8_LDA(At, 0, 0); PG8_STAGE(PG8_SA(1, 1), a1 + hstep, voffA);
            PG8_WAIT_V(8); PG8_WAIT_L(0); PG8_BAR; PG8_MMA(0, 0, At, B0); PG8_MMA(0, 1, At, B1); PG8_BAR; PG8_SCHED;
            PG8_LDA(At, 0, 1); PG8_STAGE(PG8_SB(0, 0), b2, voffB); PG8_STAGE(PG8_SB(0, 1), b2 + hstep, voffB); PG8_STAGE(PG8_SA(0, 0), a2, voffA);
            PG8_WAIT_V(8); PG8_WAIT_L(0); PG8_BAR; PG8_MMA(1, 0, At, B0); PG8_MMA(1, 1, At, B1); PG8_BAR; PG8_SCHED;
            PG8_LDB(B0, 1, 0); PG8_LDB(B1, 1, 1); PG8_SCHED; PG8_LDA(At, 1, 0); PG8_STAGE(PG8_SA(0, 1), a2 + hstep, voffA);
            PG8_WAIT_V(8); PG8_WAIT_L(0); PG8_BAR; PG8_MMA(0, 0, At, B0); PG8_MMA(0, 1, At, B1); PG8_BAR; PG8_SCHED;
            PG8_LDA(At, 1, 1); PG8_STAGE(PG8_SB(1, 0), b3, voffB); PG8_STAGE(PG8_SB(1, 1), b3 + hstep, voffB); PG8_STAGE(PG8_SA(1, 0), a3, voffA);
            PG8_WAIT_V(8); PG8_WAIT_L(0); PG8_BAR; PG8_MMA(1, 0, At, B0); PG8_MMA(1, 1, At, B1); PG8_BAR; PG8_SCHED;
            } else {
            PG8_LDB(B0, 0, 0); PG8_SCHED; PG8_LDA(At, 0, 0); PG8_STAGE(PG8_SA(1, 1), a1 + hstep, voffA);
            PG8_WAIT_L(8); PG8_BAR; PG8_WAIT_L(0); PG8_MMA(0, 0, At, B0); PG8_BAR; PG8_SCHED;
            PG8_LDB(B1, 0, 1); PG8_STAGE(PG8_SB(0, 0), b2, voffB);
            PG8_BAR; PG8_WAIT_L(0); PG8_MMA(0, 1, At, B1); PG8_BAR;
            PG8_LDA(At, 0, 1); PG8_STAGE(PG8_SA(0, 0), a2, voffA);
            PG8_BAR; PG8_WAIT_L(0); PG8_MMA(1, 0, At, B0); PG8_BAR; PG8_SCHED;
            PG8_STAGE(PG8_SB(0, 1), b2 + hstep, voffB);
            PG8_WAIT_V(6); PG8_BAR; PG8_MMA(1, 1, At, B1); PG8_BAR;
            PG8_LDB(B0, 1, 0); PG8_SCHED; PG8_LDA(At, 1, 0); PG8_STAGE(PG8_SA(0, 1), a2 + hstep, voffA);
            PG8_WAIT_L(8); PG8_BAR; PG8_WAIT_L(0); PG8_MMA(0, 0, At, B0); PG8_BAR; PG8_SCHED;
            PG8_LDB(B1, 1, 1); PG8_STAGE(PG8_SB(1, 0), b3, voffB);
            PG8_BAR; PG8_WAIT_L(0); PG8_MMA(0, 1, At, B1); PG8_BAR;
            PG8_LDA(At, 1, 1); PG8_STAGE(PG8_SA(1, 0), a3, voffA);
            PG8_BAR; PG8_WAIT_L(0); PG8_MMA(1, 0, At, B0); PG8_BAR; PG8_SCHED;
            PG8_STAGE(PG8_SB(1, 1), b3 + hstep, voffB);
            PG8_WAIT_V(6); PG8_BAR; PG8_MMA(1, 1, At, B1); PG8_BAR;
            }
        }
        if constexpr (ALIGN_EPI) { if (wr == 0) PG8_BAR; }
        if constexpr (!Epi::AFTER_DRAIN) { E(acc, cur, wr, wc, fr, fq); S.done(cur); }
        if (!has_next) break;
#pragma unroll
        for (int a = 0; a < 2; ++a)
#pragma unroll
            for (int b = 0; b < 2; ++b)
#pragma unroll
                for (int m = 0; m < 4; ++m)
#pragma unroll
                    for (int n = 0; n < 2; ++n) acc[a][b][m][n] = (f32x4){0.f, 0.f, 0.f, 0.f};
        cur = nxt; cA = nA; cB = nB; ++ui;
        if constexpr (ALIGN_EPI) { if (wr == 1) PG8_BAR; }
    }
    PG8_WAIT_V(0);
    if constexpr (!ALIGN_EPI) { if (wr == 0) PG8_BAR; }
    PG8_BAR;
    if constexpr (Epi::AFTER_DRAIN) { E.fused(acc, cur, wr, wc, fr, fq, lds, wid, lane); S.done(cur); }
#undef PG8_SA
#undef PG8_SB
#undef PG8_STAGE
#undef PG8_LDA
#undef PG8_LDB
#undef PG8_MMA
#undef PG8_WAIT_V
#undef PG8_WAIT_L
#undef PG8_BAR
#undef PG8_SCHED
}
}
#ifndef PG8_SP2
#define PG8_SP2 true
#endif
#ifndef PG8_ALIGN
#define PG8_ALIGN true
#endif
#ifndef MK_DUP
#define MK_DUP -1
#endif
#ifndef MK_COOP
#define MK_COOP 1
#endif

#define GAS __attribute__((address_space(1)))
#define LAS __attribute__((address_space(3)))
typedef unsigned short bf16;
typedef unsigned v4u __attribute__((ext_vector_type(4)));
typedef unsigned v2u __attribute__((ext_vector_type(2)));
typedef float f32x4 __attribute__((ext_vector_type(4)));
typedef float f32x16 __attribute__((ext_vector_type(16)));
typedef short bf16x8 __attribute__((ext_vector_type(8)));
typedef short s16x4 __attribute__((ext_vector_type(4)));
#define LDS_WAIT() asm volatile("s_waitcnt lgkmcnt(0)" ::: "memory")
__device__ __forceinline__ unsigned pk2(float lo, float hi) { return pg8::cvt_pk_bf16(lo, hi); }
__device__ __forceinline__ float bf_lo(unsigned w) { return __builtin_bit_cast(float, w << 16); }
__device__ __forceinline__ float bf_hi(unsigned w) { return __builtin_bit_cast(float, w & 0xffff0000u); }

constexpr int NWAVES = 8;
constexpr int BATCH = 16, SEQ = 2048, D = 1024, FF = 4096, INW = 2304, M = BATCH * SEQ;
constexpr int NMOD = 6 * D;
constexpr float EPS = 1e-6f;
constexpr int NPH = 10;
constexpr size_t MiB = 1u << 20;
constexpr size_t WS_CTL = 0, WS_WIN = 2 * MiB, WS_WOUT = 7 * MiB, WS_WUP = 9 * MiB, WS_WDN = 17 * MiB, WS_MOD = 25 * MiB, WS_ROPE = 26 * MiB, WS_LSE = 28 * MiB;
constexpr size_t WS_XN = 36 * MiB, WS_PROJ = 100 * MiB, WS_MIXED = 244 * MiB, WS_PART = 308 * MiB, WS_H = 100 * MiB, WS_Y = 420 * MiB  , WS_X1 = 356 * MiB  , WS_Y2 = 36 * MiB, WS_END = 484 * MiB;
constexpr int LDS_BYTES = 155648;

struct Frame {
    LAS unsigned char* lds;
    int tid, lane, wave, G;
    const float *x, *c, *w_ada, *b_ada, *g_attn_pre, *g_attn_post, *w_in, *sink_a, *g_mix_a, *g_mix_b, *w_out, *g_mlp_pre, *g_mlp_post, *w_up, *w_down;
    const int* positions;
    float* out;
    bf16 *Win_t, *Wout_t, *Wup_t, *Wdn_t, *XN, *PROJ, *MIXED, *PART, *HB;
    float *MOD, *ROPE, *LSE, *X1, *RS1; bf16 *Y1, *Y2;
};

__device__ __forceinline__ float wave_sum(float v) {
#pragma unroll
    for (int o = 1; o < 64; o <<= 1) v += __shfl_xor(v, o);
    return v;
}
__device__ __forceinline__ void p0_transpose_item(const float* W, int K, int N, bf16* WT, LAS float* scr, int item, int lane) {
    const int nblk = N / 32, kb = item / nblk, nb = item % nblk, k0 = 64 * kb, n0 = 32 * nb;
    float wv[32];
#pragma unroll
    for (int i = 0; i < 32; ++i) wv[i] = __builtin_nontemporal_load(W + (size_t)(k0 + 2 * i + (lane >> 5)) * N + n0 + (lane & 31));
#pragma unroll
    for (int i = 0; i < 32; ++i) scr[(2 * i + (lane >> 5)) * 33 + (lane & 31)] = wv[i];
    LDS_WAIT(); asm volatile("" ::: "memory");
    const int c = lane & 7;
#pragma unroll
    for (int j = 0; j < 4; ++j) { const int n = (lane >> 3) + 8 * j; const LAS float* s = scr + (8 * c) * 33 + n;
        v4u o; o.x = pk2(s[0 * 33], s[1 * 33]); o.y = pk2(s[2 * 33], s[3 * 33]); o.z = pk2(s[4 * 33], s[5 * 33]); o.w = pk2(s[6 * 33], s[7 * 33]);
        *(GAS v4u*)(WT + (size_t)(n0 + n) * K + k0 + 8 * c) = o; }
    LDS_WAIT(); asm volatile("" ::: "memory");
}
__device__ __forceinline__ double inv_freq_d(int i) {
    switch (i) { case 0: return 1.0; case 1: return 0.19392274474868576; case 2: return 0.03760603093086393; case 3: return 0.007292664737217109;
                 case 4: return 0.001414213562373095; case 5: return 0.0002742481756762073; case 6: return 5.318295896944988e-05; default: return 1.031338537721246e-05; }
}
__device__ __forceinline__ void sincos_d(double ang, float& cs, float& sn) {
    const double t = ang * 0.15915494309189535;
    const double fr = t - __builtin_rint(t);
    const double kq = __builtin_rint(fr * 4.0);
    const double y = (fr - kq * 0.25) * 6.283185307179586;
    const double y2 = y * y;
    double s = -1.0 / 1307674368000.0; s = s * y2 + 1.0 / 6227020800.0; s = s * y2 - 1.0 / 39916800.0; s = s * y2 + 1.0 / 362880.0; s = s * y2 - 1.0 / 5040.0; s = s * y2 + 1.0 / 120.0; s = s * y2 - 1.0 / 6.0; s = s * y2 + 1.0; s = s * y;
    double c = 1.0 / 87178291200.0; c = c * y2 - 1.0 / 479001600.0; c = c * y2 + 1.0 / 3628800.0; c = c * y2 - 1.0 / 40320.0; c = c * y2 + 1.0 / 720.0; c = c * y2 - 1.0 / 24.0; c = c * y2 + 0.5; c = 1.0 - c * y2;
    const int k = ((int)kq) & 3;
    double co = c, so = s;
    if (k == 1) { co = -s; so = c; } else if (k == 2) { co = -c; so = -s; } else if (k == 3) { co = s; so = -c; }
    cs = (float)co; sn = (float)so;
}

__device__ __forceinline__ void p0_prologue(Frame& F) {
    if ((int)blockIdx.x < NMOD / 64) {
        LAS float* condT = (LAS float*)F.lds;
        LAS float* red = (LAS float*)(F.lds + 65536);
        { float cvv[32];
#pragma unroll
          for (int j = 0; j < 32; ++j) cvv[j] = F.c[F.tid + j * (NWAVES * 64)];
#pragma unroll
          for (int j = 0; j < 32; ++j) { const int idx = F.tid + j * (NWAVES * 64), b = idx >> 10, k = idx & 1023; condT[k * 16 + b] = cvv[j] / (1.f + __expf(-cvv[j])); } }
        __syncthreads();
        for (int it = blockIdx.x; it < NMOD / 64; it += F.G) {
            const int n = it * 64 + F.lane, k0 = F.wave * 128;
            float acc[16];
#pragma unroll
            for (int b = 0; b < 16; ++b) acc[b] = 0.f;
#pragma unroll 1
            for (int kb = k0; kb < k0 + 128; kb += 16) {
                const float* wp = F.w_ada + (size_t)kb * NMOD + n;
                f32x4 w0, w1, w2, w3;
                w0[0] = wp[0]; w0[1] = wp[NMOD]; w0[2] = wp[2 * NMOD]; w0[3] = wp[3 * NMOD]; w1[0] = wp[4 * NMOD]; w1[1] = wp[5 * NMOD]; w1[2] = wp[6 * NMOD]; w1[3] = wp[7 * NMOD];
                w2[0] = wp[8 * NMOD]; w2[1] = wp[9 * NMOD]; w2[2] = wp[10 * NMOD]; w2[3] = wp[11 * NMOD]; w3[0] = wp[12 * NMOD]; w3[1] = wp[13 * NMOD]; w3[2] = wp[14 * NMOD]; w3[3] = wp[15 * NMOD];
                asm volatile("" : "+v"(w0), "+v"(w1), "+v"(w2), "+v"(w3));
#pragma unroll
                for (int j = 0; j < 16; ++j) { const float w = j < 4 ? w0[j & 3] : (j < 8 ? w1[j & 3] : (j < 12 ? w2[j & 3] : w3[j & 3]));
                    const LAS f32x4* cp = (const LAS f32x4*)(condT + (kb + j) * 16);
#pragma unroll
                    for (int q = 0; q < 4; ++q) { const f32x4 cv = cp[q]; acc[4 * q + 0] += cv[0] * w; acc[4 * q + 1] += cv[1] * w; acc[4 * q + 2] += cv[2] * w; acc[4 * q + 3] += cv[3] * w; }
                    asm volatile("" : "+v"(acc[0]), "+v"(acc[15])); }
            }
#pragma unroll
            for (int b = 0; b < 16; ++b) red[(F.wave * 16 + b) * 64 + F.lane] = acc[b];
            __syncthreads();
            for (int o = F.tid; o < 1024; o += NWAVES * 64) { const int b = o >> 6, col = o & 63; float s = 0.f;
#pragma unroll
                for (int w = 0; w < 8; ++w) s += red[(w * 16 + b) * 64 + col];
                F.MOD[b * NMOD + it * 64 + col] = s + F.b_ada[it * 64 + col]; }
            __syncthreads();
        }
    }
    __syncthreads();
    LAS float* scr = (LAS float*)(F.lds + F.wave * 16384);
    const int gw = blockIdx.x * NWAVES + F.wave, NGW = F.G * NWAVES;
    constexpr int I_IN = (D / 64) * (INW / 32), I_OUT = (D / 64) * (D / 32), I_UP = (D / 64) * (FF / 32), I_DN = (FF / 64) * (D / 32);
    constexpr int NITEMS = I_IN + I_OUT + I_UP + I_DN;
    const int TB0 = (F.G == 256) ? NMOD / 64 : 0, tgw = ((int)blockIdx.x - TB0) * NWAVES + F.wave, TNGW = (F.G - TB0) * NWAVES;
    for (int it = ((int)blockIdx.x >= TB0) ? tgw : NITEMS; it < NITEMS; it += TNGW) {
        int r = it;
        if (r < I_IN) { p0_transpose_item(F.w_in, D, INW, F.Win_t, scr, r, F.lane); continue; } r -= I_IN;
        if (r < I_OUT) { p0_transpose_item(F.w_out, D, D, F.Wout_t, scr, r, F.lane); continue; } r -= I_OUT;
        if (r < I_UP) { p0_transpose_item(F.w_up, D, FF, F.Wup_t, scr, r, F.lane); continue; } r -= I_UP;
        p0_transpose_item(F.w_down, FF, D, F.Wdn_t, scr, r, F.lane);
    }
    for (int idx = blockIdx.x * (NWAVES * 64) + F.tid; idx < M * 8; idx += F.G * NWAVES * 64) {
        const int row = idx >> 3, i = idx & 7;
        const float angf = (float)F.positions[row] * (float)inv_freq_d(i);
        float cs, sn; sincos_d((double)angf, cs, sn);
        F.ROPE[row * 16 + i] = cs; F.ROPE[row * 16 + 8 + i] = sn;
    }
}

__device__ __forceinline__ void p1_prenorm(Frame& F) {
    const int gw = blockIdx.x * NWAVES + F.wave, NGW = F.G * NWAVES;
    for (int m0 = 4 * gw; m0 < M; m0 += 4 * NGW) {
        const int b = m0 / SEQ; const float* mod = F.MOD + b * NMOD;
        f32x4 v[4][4]; float s[4] = {0.f, 0.f, 0.f, 0.f};
#pragma unroll
        for (int t = 0; t < 4; ++t) { const f32x4* xr = (const f32x4*)(F.x + (size_t)(m0 + t) * D) + F.lane;
#pragma unroll
            for (int j = 0; j < 4; ++j) v[t][j] = __builtin_nontemporal_load(xr + 64 * j); }
#pragma unroll
        for (int t = 0; t < 4; ++t)
#pragma unroll
            for (int j = 0; j < 4; ++j) s[t] += (v[t][j].x * v[t][j].x + v[t][j].y * v[t][j].y) + (v[t][j].z * v[t][j].z + v[t][j].w * v[t][j].w);
        float rs[4];
#pragma unroll
        for (int t = 0; t < 4; ++t) rs[t] = 1.0f / sqrtf(wave_sum(s[t]) * (1.f / D) + EPS);
#pragma unroll
        for (int j = 0; j < 4; ++j) { const int col = 4 * F.lane + 256 * j;
            const f32x4 g = *(const f32x4*)(F.g_attn_pre + col), sh = *(const f32x4*)(mod + col), sc = *(const f32x4*)(mod + D + col);
#pragma unroll
            for (int t = 0; t < 4; ++t) { unsigned long long* o8 = (unsigned long long*)(F.XN + (size_t)(m0 + t) * D) + F.lane;
                const f32x4 h = (v[t][j] * rs[t] * g) * (sc + 1.f) + sh;
                o8[64 * j] = (unsigned long long)pk2(h.x, h.y) | ((unsigned long long)pk2(h.z, h.w) << 32); } }
    }
}
__device__ __forceinline__ void p4_combine(Frame& F) {
    const int gw = blockIdx.x * NWAVES + F.wave, NGW = F.G * NWAVES;
    constexpr size_t PSTR = (size_t)M * 512;
    const int hd = F.lane >> 3;
    const f32x4 ga0 = *(const f32x4*)(F.g_mix_a + 8 * F.lane), ga1 = *(const f32x4*)(F.g_mix_a + 8 * F.lane + 4), gb0 = *(const f32x4*)(F.g_mix_b + 8 * F.lane), gb1 = *(const f32x4*)(F.g_mix_b + 8 * F.lane + 4);
    for (int m0 = 4 * gw; m0 < M; m0 += 4 * NGW) {
        v4u pa[4], p1[4], p2[4], p3[4]; float l1[4], l2[4], l3[4];
#pragma unroll
        for (int t = 0; t < 4; ++t) { const int m = m0 + t; const size_t off = (size_t)m * 512 + 8 * F.lane;
            pa[t] = __builtin_nontemporal_load((const v4u*)(F.PART + off)); p1[t] = __builtin_nontemporal_load((const v4u*)(F.PART + PSTR + off)); p2[t] = __builtin_nontemporal_load((const v4u*)(F.PART + 2 * PSTR + off)); p3[t] = __builtin_nontemporal_load((const v4u*)(F.PART + 3 * PSTR + off));
            l1[t] = F.LSE[(size_t)hd * M + m]; l2[t] = F.LSE[(size_t)(8 + hd) * M + m]; l3[t] = F.LSE[(size_t)(16 + hd) * M + m]; }
#pragma unroll
        for (int t = 0; t < 4; ++t) { const int m = m0 + t;
            const float mx = fmaxf(l1[t], fmaxf(l2[t], l3[t]));
            float w1 = __expf(l1[t] - mx), w2 = __expf(l2[t] - mx), w3 = __expf(l3[t] - mx); const float inv = 1.f / (w1 + w2 + w3); w1 *= inv; w2 *= inv; w3 *= inv;
            float oa[8], ob[8]; float sa = 0.f, sb = 0.f;
#pragma unroll
            for (int q = 0; q < 4; ++q) {
                oa[2 * q] = bf_lo(pa[t][q]); oa[2 * q + 1] = bf_hi(pa[t][q]);
                ob[2 * q] = w1 * bf_lo(p1[t][q]) + w2 * bf_lo(p2[t][q]) + w3 * bf_lo(p3[t][q]); ob[2 * q + 1] = w1 * bf_hi(p1[t][q]) + w2 * bf_hi(p2[t][q]) + w3 * bf_hi(p3[t][q]);
                sa += oa[2 * q] * oa[2 * q] + oa[2 * q + 1] * oa[2 * q + 1]; sb += ob[2 * q] * ob[2 * q] + ob[2 * q + 1] * ob[2 * q + 1]; }
            const float ra = 1.0f / sqrtf(wave_sum(sa) * (1.f / 512.f) + EPS), rb = 1.0f / sqrtf(wave_sum(sb) * (1.f / 512.f) + EPS);
            v4u wa, wb;
            wa.x = pk2(oa[0] * ra * ga0[0], oa[1] * ra * ga0[1]); wa.y = pk2(oa[2] * ra * ga0[2], oa[3] * ra * ga0[3]); wa.z = pk2(oa[4] * ra * ga1[0], oa[5] * ra * ga1[1]); wa.w = pk2(oa[6] * ra * ga1[2], oa[7] * ra * ga1[3]);
            wb.x = pk2(ob[0] * rb * gb0[0], ob[1] * rb * gb0[1]); wb.y = pk2(ob[2] * rb * gb0[2], ob[3] * rb * gb0[3]); wb.z = pk2(ob[4] * rb * gb1[0], ob[5] * rb * gb1[1]); wb.w = pk2(ob[6] * rb * gb1[2], ob[7] * rb * gb1[3]);
            *(v4u*)(F.MIXED + (size_t)m * D + 8 * F.lane) = wa; *(v4u*)(F.MIXED + (size_t)m * D + 512 + 8 * F.lane) = wb; }
    }
}
__device__ __forceinline__ void p6_mid(Frame& F) {
    const int gw = blockIdx.x * NWAVES + F.wave, NGW = F.G * NWAVES;
    for (int m0 = 2 * gw; m0 < M; m0 += 2 * NGW) {
        const int b = m0 / SEQ; const float* mod = F.MOD + b * NMOD;
        f32x4 v[2][4], xv[2][4]; float s[2] = {0.f, 0.f};
#pragma unroll
        for (int t = 0; t < 2; ++t) { const v2u* yr = (const v2u*)(F.Y1 + (size_t)(m0 + t) * D) + F.lane; const f32x4* xr = (const f32x4*)(F.x + (size_t)(m0 + t) * D) + F.lane;
#pragma unroll
            for (int j = 0; j < 4; ++j) { const v2u w = __builtin_nontemporal_load(yr + 64 * j); v[t][j] = (f32x4){bf_lo(w.x), bf_hi(w.x), bf_lo(w.y), bf_hi(w.y)}; xv[t][j] = __builtin_nontemporal_load(xr + 64 * j); } }
#pragma unroll
        for (int t = 0; t < 2; ++t)
#pragma unroll
            for (int j = 0; j < 4; ++j) s[t] += (v[t][j].x * v[t][j].x + v[t][j].y * v[t][j].y) + (v[t][j].z * v[t][j].z + v[t][j].w * v[t][j].w);
        float rs[2], s2[2] = {0.f, 0.f};
#pragma unroll
        for (int t = 0; t < 2; ++t) { rs[t] = 1.0f / sqrtf(wave_sum(s[t]) * (1.f / D) + EPS); if (F.lane == 0) F.RS1[m0 + t] = rs[t]; }
#pragma unroll
        for (int j = 0; j < 4; ++j) { const int col = 4 * F.lane + 256 * j;
            const f32x4 gg = *(const f32x4*)(F.g_attn_post + col) * *(const f32x4*)(mod + 2 * D + col);
#pragma unroll
            for (int t = 0; t < 2; ++t) {
                xv[t][j] = xv[t][j] + gg * (v[t][j] * rs[t]);
                s2[t] += (xv[t][j].x * xv[t][j].x + xv[t][j].y * xv[t][j].y) + (xv[t][j].z * xv[t][j].z + xv[t][j].w * xv[t][j].w); } }
        float rs2[2];
#pragma unroll
        for (int t = 0; t < 2; ++t) rs2[t] = 1.0f / sqrtf(wave_sum(s2[t]) * (1.f / D) + EPS);
#pragma unroll
        for (int j = 0; j < 4; ++j) { const int col = 4 * F.lane + 256 * j;
            const f32x4 g = *(const f32x4*)(F.g_mlp_pre + col), sh = *(const f32x4*)(mod + 3 * D + col), sc = *(const f32x4*)(mod + 4 * D + col);
#pragma unroll
            for (int t = 0; t < 2; ++t) { unsigned long long* o8 = (unsigned long long*)(F.XN + (size_t)(m0 + t) * D) + F.lane;
                const f32x4 h = (xv[t][j] * rs2[t] * g) * (sc + 1.f) + sh;
                o8[64 * j] = (unsigned long long)pk2(h.x, h.y) | ((unsigned long long)pk2(h.z, h.w) << 32); } }
    }
}
__device__ __forceinline__ void p9_final(Frame& F) {
    const int gw = blockIdx.x * NWAVES + F.wave, NGW = F.G * NWAVES;
    for (int m0 = 2 * gw; m0 < M; m0 += 2 * NGW) {
        const int b = m0 / SEQ; const float* mod = F.MOD + b * NMOD;
        f32x4 v1[2][4], v2[2][4], xv[2][4]; float s[2] = {0.f, 0.f}, rs1[2];
#pragma unroll
        for (int t = 0; t < 2; ++t) { const v2u* y1r = (const v2u*)(F.Y1 + (size_t)(m0 + t) * D) + F.lane; const v2u* y2r = (const v2u*)(F.Y2 + (size_t)(m0 + t) * D) + F.lane; const f32x4* xr = (const f32x4*)(F.x + (size_t)(m0 + t) * D) + F.lane;
            rs1[t] = F.RS1[m0 + t];
#pragma unroll
            for (int j = 0; j < 4; ++j) { const v2u w1 = __builtin_nontemporal_load(y1r + 64 * j), w2 = __builtin_nontemporal_load(y2r + 64 * j); v1[t][j] = (f32x4){bf_lo(w1.x), bf_hi(w1.x), bf_lo(w1.y), bf_hi(w1.y)}; v2[t][j] = (f32x4){bf_lo(w2.x), bf_hi(w2.x), bf_lo(w2.y), bf_hi(w2.y)};
                xv[t][j] = __builtin_nontemporal_load(xr + 64 * j); } }
#pragma unroll
        for (int t = 0; t < 2; ++t)
#pragma unroll
            for (int j = 0; j < 4; ++j) s[t] += (v2[t][j].x * v2[t][j].x + v2[t][j].y * v2[t][j].y) + (v2[t][j].z * v2[t][j].z + v2[t][j].w * v2[t][j].w);
        float rs[2];
#pragma unroll
        for (int t = 0; t < 2; ++t) rs[t] = 1.0f / sqrtf(wave_sum(s[t]) * (1.f / D) + EPS);
#pragma unroll
        for (int j = 0; j < 4; ++j) { const int col = 4 * F.lane + 256 * j;
            const f32x4 gga = *(const f32x4*)(F.g_attn_post + col) * *(const f32x4*)(mod + 2 * D + col), ggm = *(const f32x4*)(F.g_mlp_post + col) * *(const f32x4*)(mod + 5 * D + col);
#pragma unroll
            for (int t = 0; t < 2; ++t) { f32x4* orow = (f32x4*)(F.out + (size_t)(m0 + t) * D) + F.lane;
                const f32x4 x1 = xv[t][j] + gga * (v1[t][j] * rs1[t]);
                __builtin_nontemporal_store(x1 + ggm * (v2[t][j] * rs[t]), orow + 64 * j); } }
    }
}

constexpr int VROW = 144;
constexpr int ATT_WAVE_LDS = 18432;
constexpr float SC2 = 0.125f * 1.4426950408889634f;
typedef short v4i16_t __attribute__((ext_vector_type(4)));
__device__ __forceinline__ s16x4 vtr(const LAS unsigned char* p) { return __builtin_bit_cast(s16x4, __builtin_amdgcn_ds_read_tr16_b64_v4i16((LAS v4i16_t*)p)); }

struct AttnP { int br, d, i0, kt0, qcol, kcol, vcol, maxd, h; size_t rowbase; };
__device__ __forceinline__ AttnP attn_decode(int w, int k, int wv) {
    AttnP p; const int br = k >> 1, j = 2 * w + (k & 1), h = j & 7, tg = (j >> 3) * 8 + wv, b = tg >> 5, tt = tg & 31; p.h = h;
    const int dsh = br < 2 ? 0 : (br == 2 ? 2 : 4);
    const int r = tt >> (5 - dsh), it = tt & ((32 >> dsh) - 1);
    p.br = br; p.d = 1 << dsh; p.i0 = it * 64; p.kt0 = it < 2 ? 4 - 2 * it : 0;
    p.qcol = br == 0 ? h * 64 : 768 + h * 64; p.kcol = br == 0 ? 512 + (h >> 2) * 64 : 1280 + h * 64; p.vcol = br == 0 ? 640 + (h >> 2) * 64 : 1792 + h * 64;
    p.maxd = br == 0 ? 127 : 128; p.rowbase = (size_t)b * SEQ + r;
    return p;
}
__device__ __forceinline__ void attn_loads(const bf16* P, unsigned sk, unsigned sv, unsigned lv, unsigned vstep, v4u (&kr)[4], v4u (&vr)[4]) {
    const char* Pb = (const char*)P;
#pragma unroll
    for (int i = 0; i < 4; ++i) kr[i] = *(const v4u*)(Pb + (size_t)(sk + lv + vstep * i));
#pragma unroll
    for (int i = 0; i < 4; ++i) vr[i] = *(const v4u*)(Pb + (size_t)(sv + lv + vstep * i));
}
__device__ __forceinline__ unsigned attn_tile_base(const AttnP& p, int kt, int col) { return (unsigned)(((unsigned)(col >> 6) * (unsigned)M + (unsigned)p.rowbase + (unsigned)p.d * (unsigned)(p.i0 - 128 + 32 * kt)) * 64u) * 2u; }
constexpr int QROW = 144;
__device__ __forceinline__ void attn_qload(const bf16* P, const AttnP& p, int lane, v4u (&qt)[8]) {
    const char* Pb = (const char*)P;
    const unsigned base = (unsigned)(((unsigned)(p.qcol >> 6) * (unsigned)M + (unsigned)p.rowbase + (unsigned)p.d * (unsigned)(p.i0 + (lane >> 3))) * 64u + (unsigned)(8 * (lane & 7))) * 2u, step = (unsigned)(8 * p.d * 64 * 2);
#pragma unroll
    for (int i = 0; i < 8; ++i) qt[i] = __builtin_nontemporal_load((const v4u*)(Pb + (size_t)(base + step * i)));
}
__device__ __forceinline__ void attn_qstore(LAS unsigned char* ql, int lane, const v4u (&qt)[8]) {
#pragma unroll
    for (int i = 0; i < 8; ++i) *(LAS v4u*)(ql + ((lane >> 3) + 8 * i) * QROW + (lane & 7) * 16) = qt[i];
}

struct AttnSt { float mrun[2], lrun[2]; f32x16 O0[2], O1[2]; };
template <int MASK> __device__ __forceinline__ void attn_half(AttnSt& st, const int a, f32x16 S, const bf16x8 (&va0)[2], const bf16x8 (&va1)[2], int qh  , int farlim  ) {
    if (MASK == 1) {
#pragma unroll
        for (int i = 0; i < 16; ++i) S[i] = (qh <= farlim + (8 * (i >> 2) + (i & 3))) ? S[i] : -1e30f;
    } else if (MASK == 2) {
#pragma unroll
        for (int i = 0; i < 16; ++i) S[i] = (qh >= (8 * (i >> 2) + (i & 3))) ? S[i] : -1e30f;
    }
    float mx = S[0];
#pragma unroll
    for (int i = 1; i < 16; ++i) mx = fmaxf(mx, S[i]);
    mx = fmaxf(mx, __shfl_xor(mx, 32));
    const float mnew = fmaxf(st.mrun[a], mx), alpha = __builtin_amdgcn_exp2f((st.mrun[a] - mnew) * SC2), nb = -mnew * SC2;
    float rsum = 0.f;
#pragma unroll
    for (int i = 0; i < 16; ++i) { S[i] = __builtin_amdgcn_exp2f(__builtin_fmaf(S[i], SC2, nb)); rsum += S[i]; }
    rsum += __shfl_xor(rsum, 32);
    st.lrun[a] = st.lrun[a] * alpha + rsum; st.mrun[a] = mnew;
#pragma unroll
    for (int i = 0; i < 16; ++i) { st.O0[a][i] *= alpha; st.O1[a][i] *= alpha; }
#pragma unroll
    for (int kk = 0; kk < 2; ++kk) {
        v4u pw; pw.x = pk2(S[8 * kk + 0], S[8 * kk + 1]); pw.y = pk2(S[8 * kk + 2], S[8 * kk + 3]); pw.z = pk2(S[8 * kk + 4], S[8 * kk + 5]); pw.w = pk2(S[8 * kk + 6], S[8 * kk + 7]);
        const bf16x8 pb = __builtin_bit_cast(bf16x8, pw);
        st.O0[a] = __builtin_amdgcn_mfma_f32_32x32x16_bf16(va0[kk], pb, st.O0[a], 0, 0, 0);
        st.O1[a] = __builtin_amdgcn_mfma_f32_32x32x16_bf16(va1[kk], pb, st.O1[a], 0, 0, 0); }
}
template <int KT> __device__ __forceinline__ void attn_step(AttnSt& st, const bf16* P, const AttnP& p, const AttnP& pn, unsigned lv, unsigned lvn,
                                                            LAS unsigned char* vl, const LAS unsigned char* qrd, const LAS unsigned char* trb, int lane, v4u (&kn)[4], v4u (&vn)[4]) {
    asm volatile("" ::: "memory");
#pragma unroll
    for (int i = 0; i < 4; ++i) { *(LAS v4u*)(vl + ((lane >> 3) + 8 * i) * VROW + (lane & 7) * 16) = vn[i]; *(LAS v4u*)(vl + 32 * VROW + ((lane >> 3) + 8 * i) * VROW + (lane & 7) * 16) = kn[i]; }
    if (KT < 5) attn_loads(P, attn_tile_base(p, KT + 1, p.kcol), attn_tile_base(p, KT + 1, p.vcol), lv, (unsigned)(8 * p.d * 64 * 2), kn, vn);
    else        attn_loads(P, attn_tile_base(pn, pn.kt0, pn.kcol), attn_tile_base(pn, pn.kt0, pn.vcol), lvn, (unsigned)(8 * pn.d * 64 * 2), kn, vn);
    bf16x8 kf[4];
#pragma unroll
    for (int kd = 0; kd < 4; ++kd) kf[kd] = *(const LAS bf16x8*)(qrd - 32 * VROW + kd * 32);
    constexpr bool act0 = KT <= 4, act1 = KT >= 1;
    f32x16 S0, S1;
#pragma unroll
    for (int i = 0; i < 16; ++i) { S0[i] = 0.f; S1[i] = 0.f; }
#pragma unroll
    for (int kd = 0; kd < 4; ++kd) {
        if (act0) S0 = __builtin_amdgcn_mfma_f32_32x32x16_bf16(kf[kd], *(const LAS bf16x8*)(qrd + kd * 32), S0, 0, 0, 0);
        if (act1) S1 = __builtin_amdgcn_mfma_f32_32x32x16_bf16(kf[kd], *(const LAS bf16x8*)(qrd + 32 * QROW + kd * 32), S1, 0, 0, 0);
    }
    bf16x8 va0[2], va1[2];
#pragma unroll
    for (int kk = 0; kk < 2; ++kk) {
        const s16x4 lo0 = vtr(trb + kk * 16 * VROW), up0 = vtr(trb + kk * 16 * VROW + 8 * VROW), lo1 = vtr(trb + kk * 16 * VROW + 64), up1 = vtr(trb + kk * 16 * VROW + 8 * VROW + 64);
        va0[kk] = (bf16x8){lo0[0], lo0[1], lo0[2], lo0[3], up0[0], up0[1], up0[2], up0[3]}; va1[kk] = (bf16x8){lo1[0], lo1[1], lo1[2], lo1[3], up1[0], up1[1], up1[2], up1[3]}; }
    const int qh = (lane & 31) - 4 * (lane >> 5), farlim = p.maxd - 128;
    if (act0) attn_half<KT == 0 ? 1 : (KT == 4 ? 2 : 0)>(st, 0, S0, va0, va1, qh, farlim);
    if (act1) attn_half<KT == 1 ? 1 : (KT == 5 ? 2 : 0)>(st, 1, S1, va0, va1, qh, farlim);
    asm volatile("" ::: "memory");
}

__device__ __forceinline__ void attn_phase(Frame& F) {
    const int lane = F.lane, wv = F.wave, q = lane & 31, hi = lane >> 5;
    LAS unsigned char* vl = F.lds + wv * ATT_WAVE_LDS;
    LAS unsigned char* ql = vl + 64 * VROW;
    const LAS unsigned char* qrd = ql + q * QROW + hi * 16;
    const LAS unsigned char* trb = vl + (4 * hi + ((lane & 15) >> 2)) * VROW + (16 * ((lane >> 4) & 1) + 4 * (lane & 3)) * 2;
    const bf16* P = F.PROJ;
    const int bx = blockIdx.x, w = (bx & 7) * 32 + (bx >> 3);
    if (F.G != 256) return;
    AttnP p = attn_decode(w, 0, wv), pn = attn_decode(w, 1, wv);
    v4u kn[4], vn[4];
    { v4u qt[8]; attn_qload(P, p, lane, qt); attn_qstore(ql, lane, qt); }
    unsigned lv = (unsigned)(((lane >> 3) * p.d) * 64 + 8 * (lane & 7)) * 2u, lvn = (unsigned)(((lane >> 3) * pn.d) * 64 + 8 * (lane & 7)) * 2u;
    attn_loads(P, attn_tile_base(p, p.kt0, p.kcol), attn_tile_base(p, p.kt0, p.vcol), lv, (unsigned)(8 * p.d * 64 * 2), kn, vn);
#pragma unroll 1
    for (int k = 0; k < 8; ++k) {
        AttnSt st;
#pragma unroll
        for (int a = 0; a < 2; ++a) { st.mrun[a] = p.br == 0 ? F.sink_a[p.h] * 8.0f : -5e29f; st.lrun[a] = p.br == 0 ? 1.f : 0.f;
#pragma unroll
            for (int i = 0; i < 16; ++i) { st.O0[a][i] = 0.f; st.O1[a][i] = 0.f; } }
        if (p.kt0 <= 0) attn_step<0>(st, P, p, pn, lv, lvn, vl, qrd, trb, lane, kn, vn);
        if (p.kt0 <= 1) attn_step<1>(st, P, p, pn, lv, lvn, vl, qrd, trb, lane, kn, vn);
        if (p.kt0 <= 2) attn_step<2>(st, P, p, pn, lv, lvn, vl, qrd, trb, lane, kn, vn);
        if (p.kt0 <= 3) attn_step<3>(st, P, p, pn, lv, lvn, vl, qrd, trb, lane, kn, vn);
        attn_step<4>(st, P, p, pn, lv, lvn, vl, qrd, trb, lane, kn, vn);
        v4u qt[8];
        if (k < 7) attn_qload(P, pn, lane, qt);
        attn_step<5>(st, P, p, pn, lv, lvn, vl, qrd, trb, lane, kn, vn);
        if (k < 7) { asm volatile("" ::: "memory"); attn_qstore(ql, lane, qt); }
#pragma unroll
        for (int a = 0; a < 2; ++a) {
            const float invl = 1.f / st.lrun[a];
            asm volatile("" ::: "memory");
#pragma unroll
            for (int g = 0; g < 4; ++g) {
                v2u w0, w1; w0.x = pk2(st.O0[a][4 * g] * invl, st.O0[a][4 * g + 1] * invl); w0.y = pk2(st.O0[a][4 * g + 2] * invl, st.O0[a][4 * g + 3] * invl);
                w1.x = pk2(st.O1[a][4 * g] * invl, st.O1[a][4 * g + 1] * invl); w1.y = pk2(st.O1[a][4 * g + 2] * invl, st.O1[a][4 * g + 3] * invl);
                *(LAS v2u*)(vl + q * VROW + (8 * g + 4 * hi) * 2) = w0; *(LAS v2u*)(vl + q * VROW + (32 + 8 * g + 4 * hi) * 2) = w1; }
            asm volatile("s_waitcnt lgkmcnt(0)" ::: "memory");
            v4u orw[4];
#pragma unroll
            for (int i = 0; i < 4; ++i) orw[i] = *(const LAS v4u*)(vl + ((lane >> 3) + 8 * i) * VROW + (lane & 7) * 16);
            asm volatile("s_waitcnt lgkmcnt(0)" : "+v"(orw[0]), "+v"(orw[1]), "+v"(orw[2]), "+v"(orw[3]) :: "memory");
            bf16* ob = F.PART + (size_t)p.br * M * 512 + p.h * 64 + 8 * (lane & 7);
#pragma unroll
            for (int i = 0; i < 4; ++i) *(v4u*)(ob + (p.rowbase + (size_t)p.d * (p.i0 + 32 * a + (lane >> 3) + 8 * i)) * 512) = orw[i];
#pragma unroll
            for (int i = 0; i < 4; ++i) asm volatile("v_mov_b32 %0, %0\n\tv_mov_b32 %1, %1\n\tv_mov_b32 %2, %2\n\tv_mov_b32 %3, %3" : "+v"(orw[i].x), "+v"(orw[i].y), "+v"(orw[i].z), "+v"(orw[i].w) :: "memory");
            if (p.br > 0 && hi == 0) F.LSE[((size_t)(p.br - 1) * 8 + p.h) * M + p.rowbase + (size_t)p.d * (p.i0 + 32 * a + q)] = st.mrun[a] * 0.125f + __logf(st.lrun[a]);
        }
        if (k == 7) break;
        p = pn; pn = attn_decode(w, k + 2 < 8 ? k + 2 : 7, wv);
        lv = lvn; lvn = (unsigned)(((lane >> 3) * pn.d) * 64 + 8 * (lane & 7)) * 2u;
    }
}

#define XB_TMO      128
#define XB_XCNT(j)  (256  + 64 * (j))
#define XB_XSUB(j)  (1280 + 64 * (j))
#define XB_XGEN(j)  (2304 + 64 * (j))
#define XB_TOP      3328
#define XB_TOPGEN   3392
#define XCD_BAR_WORDS 3456
#define XB_SPIN_CAP (1u << 18)

__device__ __forceinline__ unsigned xb_ld(unsigned* p)              { return __hip_atomic_load(p, __ATOMIC_RELAXED, __HIP_MEMORY_SCOPE_AGENT); }
__device__ __forceinline__ unsigned xb_add(unsigned* p, unsigned v) { return __hip_atomic_fetch_add(p, v, __ATOMIC_RELAXED, __HIP_MEMORY_SCOPE_AGENT); }
__device__ __forceinline__ unsigned xb_xcc_id() { return (unsigned)__builtin_amdgcn_s_getreg((3 << 11) | 20) & 0xFu; }
#define XB_SPIN(cond, bar) do { unsigned _sp = 0; while (cond) { __builtin_amdgcn_s_sleep(1); \
    if ((++_sp & 255u) == 0u) { if (xb_ld(&(bar)[XB_TMO])) break; if (_sp > XB_SPIN_CAP) { atomicAdd(&(bar)[XB_TMO], 1u); break; } } } } while (0)

struct XcdBarrier {
    unsigned* bar; unsigned x;
    volatile LAS unsigned* st;
};

__device__ __forceinline__ XcdBarrier xcd_barrier_post(unsigned* bar, volatile LAS unsigned* st) {
    XcdBarrier b; b.bar = bar; b.x = xb_xcc_id(); b.st = st;
    if (threadIdx.x == 0) (void)xb_add(&bar[XB_XCNT(b.x)], 1u);
    return b;
}
__device__ __forceinline__ void xcd_barrier_complete(unsigned* bar, unsigned x, unsigned& nloc, unsigned& nx) {
    const unsigned G = gridDim.x * gridDim.y * gridDim.z;
    unsigned sum, cnt, mine, sp = 0u;
    for (;;) {
        sum = 0u; cnt = 0u; mine = 0u;
#pragma unroll
        for (unsigned j = 0; j < 16; ++j) { const unsigned c = xb_ld(&bar[XB_XCNT(j)]); sum += c; cnt += (c > 0u) ? 1u : 0u; mine = (j == x) ? c : mine; }
        if (sum == G) break;
        __builtin_amdgcn_s_sleep(1);
        if ((++sp & 255u) == 0u) { if (xb_ld(&bar[XB_TMO])) break; if (sp > XB_SPIN_CAP) { atomicAdd(&bar[XB_TMO], 1u); break; } }
    }
    nloc = mine > 0u ? mine : 1u; nx = cnt > 0u ? cnt : 1u;
}

__device__ __forceinline__ void xcd_barrier(const XcdBarrier& b) {
    asm volatile("s_waitcnt vmcnt(0)" ::: "memory");
    __syncthreads();
    if (threadIdx.x == 0) {
        unsigned* bar = b.bar;
        __builtin_amdgcn_s_waitcnt(0);
        unsigned nloc = b.st[0], nx = b.st[1];
        if (nloc == 0u) { xcd_barrier_complete(bar, b.x, nloc, nx); b.st[0] = nloc; b.st[1] = nx; }
        const unsigned old = xb_add(&bar[XB_XSUB(b.x)], 1u);
        const unsigned gen = old / nloc;
        if (old + 1u == (gen + 1u) * nloc) {
            __builtin_amdgcn_fence(__ATOMIC_RELEASE, "agent");
            asm volatile("s_waitcnt vmcnt(0)" ::: "memory");
            const unsigned og = xb_add(&bar[XB_TOP], 1u);
            const unsigned tg = og / nx;
            if (og + 1u == (tg + 1u) * nx) xb_add(&bar[XB_TOPGEN], 1u);
            else XB_SPIN(xb_ld(&bar[XB_TOPGEN]) == tg, bar);
            __builtin_amdgcn_fence(__ATOMIC_ACQUIRE, "agent");
            xb_add(&bar[XB_XGEN(b.x)], 1u);
            asm volatile("s_waitcnt vmcnt(0)" ::: "memory");
        } else {
            XB_SPIN(xb_ld(&bar[XB_XGEN(b.x)]) == gen, bar);
            __builtin_amdgcn_fence(__ATOMIC_ACQUIRE, "agent");
            asm volatile("s_waitcnt vmcnt(0)" ::: "memory");
        }
    }
    __syncthreads();
}

struct Args { const void* in[16]; float* out; unsigned char* ws; int ph_lo, ph_hi; };
__global__ void __launch_bounds__(NWAVES * 64, 2) fwd_kernel(Args args) {
    extern __shared__ __attribute__((aligned(16))) unsigned char lds[];
    cooperative_groups::grid_group grid = cooperative_groups::this_grid();
    Frame F;
    F.lds = (LAS unsigned char*)lds;
    F.tid = threadIdx.x; F.lane = F.tid & 63; F.wave = __builtin_amdgcn_readfirstlane(F.tid >> 6); F.G = gridDim.x;
    unsigned char* ws = args.ws;
    F.x = (const float*)args.in[0]; F.c = (const float*)args.in[1]; F.positions = (const int*)args.in[2]; F.w_ada = (const float*)args.in[3]; F.b_ada = (const float*)args.in[4];
    F.g_attn_pre = (const float*)args.in[5]; F.g_attn_post = (const float*)args.in[6]; F.w_in = (const float*)args.in[7]; F.sink_a = (const float*)args.in[8];
    F.g_mix_a = (const float*)args.in[9]; F.g_mix_b = (const float*)args.in[10]; F.w_out = (const float*)args.in[11]; F.g_mlp_pre = (const float*)args.in[12]; F.g_mlp_post = (const float*)args.in[13];
    F.w_up = (const float*)args.in[14]; F.w_down = (const float*)args.in[15]; F.out = args.out;
    F.Win_t = (bf16*)(ws + WS_WIN); F.Wout_t = (bf16*)(ws + WS_WOUT); F.Wup_t = (bf16*)(ws + WS_WUP); F.Wdn_t = (bf16*)(ws + WS_WDN);
    F.MOD = (float*)(ws + WS_MOD); F.ROPE = (float*)(ws + WS_ROPE); F.LSE = (float*)(ws + WS_LSE); F.RS1 = (float*)(ws + WS_LSE);
    F.XN = (bf16*)(ws + WS_XN); F.PROJ = (bf16*)(ws + WS_PROJ); F.MIXED = (bf16*)(ws + WS_MIXED); F.PART = (bf16*)(ws + WS_PART); F.HB = (bf16*)(ws + WS_H); F.Y1 = (bf16*)(ws + WS_Y); F.X1 = (float*)(ws + WS_X1); F.Y2 = (bf16*)(ws + WS_Y2);
    const int lo = args.ph_lo, hi = args.ph_hi;
    unsigned* barw = (unsigned*)(ws + WS_CTL);
    volatile LAS unsigned* bst = (volatile LAS unsigned*)(F.lds + 8 * 18432 + 64);
    if (F.tid < 2) bst[F.tid] = 0u;
    if (hi - lo > 1 && blockIdx.x == 0) for (int i = F.tid; i < XCD_BAR_WORDS; i += NWAVES * 64) __hip_atomic_store(barw + i, 0u, __ATOMIC_RELAXED, __HIP_MEMORY_SCOPE_AGENT);
    __syncthreads();
    XcdBarrier bar; bar.bar = barw; bar.x = 0; bar.st = bst;
    if (hi - lo > 1) { grid.sync(); bar = xcd_barrier_post(barw, bst); }
#define IN(k) (lo <= (k) && (k) < hi)
#define SEAM0() SEAM(0)
#define SEAM(k) do { if (IN(k) && IN((k) + 1)) xcd_barrier(bar); } while (0)

    if (IN(0)) { p0_prologue(F); } SEAM0();
    if (IN(1)) { p1_prenorm(F); } SEAM(1);
    if (IN(2)) {
        pg8::Gemm g{F.XN, F.Win_t, M, INW, D}; pg8::StaticOrder S; S.init(M, INW, F.G, (int)blockIdx.x);
        pg8::EpiProj E{F.PROJ, INW, F.ROPE};
        pg8::gemm_phase<pg8::EpiProj, pg8::StaticOrder, PG8_ALIGN, PG8_SP2>(F.lds, g, S, E);
    } SEAM(2);
    if (IN(3)) { attn_phase(F); } SEAM(3);
    if (IN(4)) { p4_combine(F); } SEAM(4);
    if (IN(5)) {
        pg8::Gemm g{F.MIXED, F.Wout_t, M, D, D}; pg8::StaticOrder S; S.init(M, D, F.G, (int)blockIdx.x);
        pg8::EpiBf E{F.Y1, D};
        pg8::gemm_phase<pg8::EpiBf, pg8::StaticOrder, PG8_ALIGN, PG8_SP2>(F.lds, g, S, E);
    } SEAM(5);
    if (IN(6)) { p6_mid(F); } SEAM(6);
    if (IN(7)) {
        pg8::Gemm g{F.XN, F.Wup_t, M, FF, D}; pg8::StaticOrder S; S.init(M, FF, F.G, (int)blockIdx.x);
        pg8::EpiSqRelu E{F.HB, FF};
        pg8::gemm_phase<pg8::EpiSqRelu, pg8::StaticOrder, PG8_ALIGN, PG8_SP2>(F.lds, g, S, E);
    } SEAM(7);
    if (IN(8)) {
        pg8::Gemm g{F.HB, F.Wdn_t, M, D, FF}; pg8::StaticOrder S; S.init(M, D, F.G, (int)blockIdx.x);
        pg8::EpiBf E{F.Y2, D};
        pg8::gemm_phase<pg8::EpiBf, pg8::StaticOrder, PG8_ALIGN, PG8_SP2>(F.lds, g, S, E);
    } SEAM(8);
    if (IN(9)) { p9_final(F); }
#undef IN
#undef SEAM
#undef SEAM0
}

extern "C" void kernel_launch(void* const* d_in, const int* in_sizes, int n_in, void* d_out, int out_size, void* d_ws, size_t ws_size, hipStream_t stream) {
    static int grid = 0;
    if (grid == 0) {
        if (n_in != 16 || in_sizes[0] != M * D || out_size != M * D || ws_size < WS_END) { fprintf(stderr, "kernel_launch: unexpected shapes (n_in %d, in0 %d, out %d, ws %zu); nothing launched\n", n_in, n_in > 0 ? in_sizes[0] : -1, out_size, ws_size); grid = -1; return; }
        int dev = 0, cus = 0, per_cu = 0;
        if (hipGetDevice(&dev) != hipSuccess || hipDeviceGetAttribute(&cus, hipDeviceAttributeMultiprocessorCount, dev) != hipSuccess) { grid = -1; return; }
        if (hipFuncSetAttribute((const void*)fwd_kernel, hipFuncAttributeMaxDynamicSharedMemorySize, LDS_BYTES) != hipSuccess) { fprintf(stderr, "kernel_launch: hipFuncSetAttribute failed\n"); grid = -1; return; }
        if (hipOccupancyMaxActiveBlocksPerMultiprocessor(&per_cu, (const void*)fwd_kernel, NWAVES * 64, LDS_BYTES) != hipSuccess || per_cu < 1) { fprintf(stderr, "kernel_launch: occupancy query says %d\n", per_cu); per_cu = 1; }
        (void)hipGetLastError();
        grid = cus * per_cu;
    }
    if (grid < 0) return;
    Args a{};
    for (int i = 0; i < 16; ++i) a.in[i] = d_in[i];
    a.out = (float*)d_out; a.ws = (unsigned char*)d_ws;
#if MK_COOP
    a.ph_lo = 0; a.ph_hi = NPH;
    void* kargs[] = {&a};
    hipError_t e = hipLaunchCooperativeKernel((const void*)fwd_kernel, dim3(grid), dim3(NWAVES * 64), kargs, LDS_BYTES, stream);
    if (e != hipSuccess) fprintf(stderr, "kernel_launch: cooperative launch failed: %s (grid %d)\n", hipGetErrorString(e), grid);
#else
    for (int ph = 0; ph < NPH; ++ph) { a.ph_lo = ph; a.ph_hi = ph + 1; const int reps = (ph == MK_DUP) ? 2 : 1;
        for (int rp = 0; rp < reps; ++rp) hipLaunchKernelGGL(fwd_kernel, dim3(grid), dim3(NWAVES * 64), LDS_BYTES, stream, a); }
#endif
}
```
